# Optimizing an MI355X kernel written in HIP

```python
import jax, jax.numpy as jnp
from jax import lax
import numpy as np

D_MODEL = 1024
BATCH = 8
SEQ = 4096
DEPTH = 4

N_MEM = 256
HEAD_DIM = 64
N_MIX_HEADS = 12
MIX_WIDTH = N_MIX_HEADS * HEAD_DIM
N_MEM_HEADS = 4
MEM_WIDTH = N_MEM_HEADS * HEAD_DIM
D_FF = 2816
CHUNK = 128
BLOCK_Q = 128
ROPE_THETA = 10000.0
DILATED_GROUPS = ((128, 1), (512, 4), (2048, 16))
HEADS_PER_DIL_GROUP = N_MIX_HEADS // len(DILATED_GROUPS)
DIL_OUT_WIDTH = HEADS_PER_DIL_GROUP * HEAD_DIM
RMS_EPS = 1e-6
LN_EPS = 1e-5
NEG_INF = -1e30
ATTN_SCALE = HEAD_DIM ** -0.5
MAX_POS_OFFSET = 1024
N_NORMS = 6

N_A = (DEPTH + 2) // 3
N_B = (DEPTH + 1) // 3
N_C = DEPTH // 3
A_IN = 2 * MIX_WIDTH + MEM_WIDTH
A_OUT = MIX_WIDTH + MEM_WIDTH
B_IN = 3 * MIX_WIDTH + MEM_WIDTH
B_OUT = DIL_OUT_WIDTH + MEM_WIDTH
C_IN = 3 * MIX_WIDTH + N_MIX_HEADS + MEM_WIDTH
C_OUT = MIX_WIDTH + MEM_WIDTH

kernel_name = 'hybrid_interleaved_gmlp_dilated_fox_macaron'


def rms_norm(x, g):
    xf = x.astype(jnp.float32)
    y = xf * lax.rsqrt(jnp.mean(xf * xf, axis=-1, keepdims=True) + RMS_EPS)
    return (y * g.astype(jnp.float32)).astype(x.dtype)


def layer_norm(x, g):
    xf = x.astype(jnp.float32)
    mu = jnp.mean(xf, axis=-1, keepdims=True)
    var = jnp.mean(jnp.square(xf - mu), axis=-1, keepdims=True)
    return ((xf - mu) * lax.rsqrt(var + LN_EPS) * g.astype(jnp.float32)).astype(x.dtype)


def swiglu_ffn(x, w_gate_up, w_down):
    gate, up = jnp.split(x @ w_gate_up, 2, axis=-1)
    return (jax.nn.silu(gate) * up) @ w_down


def rope_tables(positions):
    inv_freq = ROPE_THETA ** (-jnp.arange(0, HEAD_DIM, 2, dtype=jnp.float32) / HEAD_DIM)
    ang = positions.astype(jnp.float32)[..., None] * inv_freq
    return jnp.cos(ang), jnp.sin(ang)


def apply_rope(t, cos, sin):
    c = cos[:, :, None, :].astype(t.dtype)
    s = sin[:, :, None, :].astype(t.dtype)
    t1, t2 = jnp.split(t, 2, axis=-1)
    return jnp.concatenate([t1 * c - t2 * s, t2 * c + t1 * s], axis=-1)


def memory_attention(q_mem, mem_n, w_mem_kv):
    B, S, _ = q_mem.shape
    k, v = jnp.split(mem_n @ w_mem_kv, 2, axis=-1)
    q = q_mem.reshape(B, S, N_MEM_HEADS, HEAD_DIM)
    k = k.reshape(B, -1, N_MEM_HEADS, HEAD_DIM)
    v = v.reshape(B, -1, N_MEM_HEADS, HEAD_DIM)
    s = jnp.einsum('bqhd,bkhd->bhqk', q, k).astype(jnp.float32) * ATTN_SCALE
    p = jax.nn.softmax(s, axis=-1).astype(v.dtype)
    return jnp.einsum('bhqk,bkhd->bqhd', p, v).reshape(B, S, MEM_WIDTH)


def mixer_a(h, mem_n, w_mem_kv, w_in, spatial_w, spatial_b, v_norm_g, w_out):
    B, S, _ = h.shape
    proj = h @ w_in
    uv, q_mem = proj[..., :2 * MIX_WIDTH], proj[..., 2 * MIX_WIDTH:]
    u, v = jnp.split(jax.nn.gelu(uv), 2, axis=-1)
    v = layer_norm(v, v_norm_g).reshape(B, S // CHUNK, CHUNK, N_MIX_HEADS, HEAD_DIM)
    w_causal = spatial_w * jnp.tril(jnp.ones((CHUNK, CHUNK), spatial_w.dtype))
    mixed = jnp.einsum('gts,bcsgd->bctgd', w_causal, v) + spatial_b.T[None, None, :, :, None]
    gated = u * mixed.reshape(B, S, MIX_WIDTH)
    y = jnp.concatenate([gated, memory_attention(q_mem, mem_n, w_mem_kv)], axis=-1)
    return y @ w_out


def dilated_window_attention(q, k, v, window, dilation):
    B, S, H, Dh = q.shape
    span = window // dilation
    L = S // dilation
    nb = -(-L // span)
    Lp = nb * span

    def to_blocks(t):
        t = t.reshape(B, L, dilation, H, Dh).transpose(0, 2, 1, 3, 4)
        t = jnp.pad(t, ((0, 0), (0, 0), (0, Lp - L), (0, 0), (0, 0)))
        return t.reshape(B, dilation, nb, span, H, Dh)

    def with_prev(t):
        prev = jnp.pad(t, ((0, 0), (0, 0), (1, 0), (0, 0), (0, 0), (0, 0)))[:, :, :-1]
        return jnp.concatenate([prev, t], axis=3)

    qb = to_blocks(q)
    kk = with_prev(to_blocks(k))
    vv = with_prev(to_blocks(v))
    s = jnp.einsum('brnqhd,brnkhd->brnhqk', qb, kk).astype(jnp.float32) * ATTN_SCALE
    qi = jnp.arange(span)[:, None] + span
    ki = jnp.arange(2 * span)[None, :]
    dist = qi - ki
    band = (dist >= 0) & (dist <= span)
    first = jnp.arange(nb)[:, None, None] == 0
    valid = band[None] & ~(first & (ki < span)[None])
    s = jnp.where(valid[None, None, :, None], s, NEG_INF)
    m = jnp.max(s, axis=-1, keepdims=True)
    p = jnp.exp(s - m)
    denom = jnp.sum(p, axis=-1, keepdims=True)
    out = jnp.einsum('brnhqk,brnkhd->brnqhd', (p / denom).astype(v.dtype), vv)
    lse = (m + jnp.log(denom))[..., 0]
    out = out.reshape(B, dilation, Lp, H, Dh)[:, :, :L].transpose(0, 2, 1, 3, 4).reshape(B, S, H, Dh)
    lse = lse.transpose(0, 1, 2, 4, 3).reshape(B, dilation, Lp, H)[:, :, :L]
    lse = lse.transpose(0, 2, 1, 3).reshape(B, S, H)
    return out, lse


def mixer_b(h, mem_n, w_mem_kv, cos, sin, w_in, w_out):
    B, S, _ = h.shape
    q, k, v, q_mem = jnp.split(h @ w_in, [MIX_WIDTH, 2 * MIX_WIDTH, 3 * MIX_WIDTH], axis=-1)
    q = apply_rope(q.reshape(B, S, N_MIX_HEADS, HEAD_DIM), cos, sin)
    k = apply_rope(k.reshape(B, S, N_MIX_HEADS, HEAD_DIM), cos, sin)
    v = v.reshape(B, S, N_MIX_HEADS, HEAD_DIM)
    outs, lses = [], []
    for g, (window, dilation) in enumerate(DILATED_GROUPS):
        hs = slice(g * HEADS_PER_DIL_GROUP, (g + 1) * HEADS_PER_DIL_GROUP)
        o, l = dilated_window_attention(q[:, :, hs], k[:, :, hs], v[:, :, hs], window, dilation)
        outs.append(o)
        lses.append(l)
    wts = jax.nn.softmax(jnp.stack(lses, axis=0), axis=0)
    merged = jnp.sum(wts[..., None].astype(v.dtype) * jnp.stack(outs, axis=0), axis=0)
    merged = merged.reshape(B, S, DIL_OUT_WIDTH)
    y = jnp.concatenate([merged, memory_attention(q_mem, mem_n, w_mem_kv)], axis=-1)
    return y @ w_out


def forgetting_attention(q, k, v, log_f):
    B, S, H, Dh = q.shape
    c = jnp.cumsum(log_f.astype(jnp.float32), axis=1).transpose(0, 2, 1)
    q_idx = jnp.arange(BLOCK_Q)
    outs = []
    for i in range(S // BLOCK_Q):
        lo, hi = i * BLOCK_Q, (i + 1) * BLOCK_Q
        s = jnp.einsum('bqhd,bkhd->bhqk', q[:, lo:hi], k[:, :hi]).astype(jnp.float32) * ATTN_SCALE
        s = s + c[:, :, lo:hi, None] - c[:, :, None, :hi]
        causal = (lo + q_idx)[:, None] >= jnp.arange(hi)[None, :]
        p = jax.nn.softmax(jnp.where(causal, s, NEG_INF), axis=-1).astype(v.dtype)
        outs.append(jnp.einsum('bhqk,bkhd->bqhd', p, v[:, :hi]))
    return jnp.concatenate(outs, axis=1)


def mixer_c(h, mem_n, w_mem_kv, w_in, forget_bias, w_out):
    B, S, _ = h.shape
    q, k, v, f_logit, q_mem = jnp.split(
        h @ w_in, [MIX_WIDTH, 2 * MIX_WIDTH, 3 * MIX_WIDTH, 3 * MIX_WIDTH + N_MIX_HEADS], axis=-1)
    log_f = jax.nn.log_sigmoid(f_logit.astype(jnp.float32) + forget_bias.astype(jnp.float32))
    heads = lambda t: t.reshape(B, S, N_MIX_HEADS, HEAD_DIM)
    att = forgetting_attention(heads(q), heads(k), heads(v), log_f).reshape(B, S, MIX_WIDTH)
    y = jnp.concatenate([att, memory_attention(q_mem, mem_n, w_mem_kv)], axis=-1)
    return y @ w_out


def setup_inputs(seed: int = 0) -> dict:
    key = jax.random.key(seed)
    ks = jax.random.split(key, 20)
    f32 = jnp.float32

    def dense(k, shape, fan_in):
        return jax.random.normal(k, shape, f32) * fan_in ** -0.5

    def gain(k, shape):
        return 1.0 + 0.02 * jax.random.normal(k, shape, f32)

    x = jax.random.normal(ks[0], (BATCH, SEQ, D_MODEL), f32)
    mem = jax.random.normal(ks[1], (BATCH, N_MEM, D_MODEL), f32)
    offset = jax.random.randint(ks[2], (BATCH, 1), 0, MAX_POS_OFFSET, dtype=jnp.int32)
    positions = (offset + jnp.arange(SEQ, dtype=jnp.int32)[None, :]).astype(jnp.int32)
    return {
        'x': x,
        'mem': mem,
        'positions': positions,
        'norm_g': gain(ks[3], (DEPTH, N_NORMS, D_MODEL)),
        'mem_norm_g': gain(ks[4], (DEPTH, D_MODEL)),
        'w_mem_kv': dense(ks[5], (DEPTH, D_MODEL, 2 * MEM_WIDTH), D_MODEL),
        'ffn_w_gate_up': dense(ks[6], (DEPTH, 2, D_MODEL, 2 * D_FF), D_MODEL),
        'ffn_w_down': dense(ks[7], (DEPTH, 2, D_FF, D_MODEL), D_FF),
        'a_w_in': dense(ks[8], (N_A, D_MODEL, A_IN), D_MODEL),
        'a_spatial_w': dense(ks[9], (N_A, N_MIX_HEADS, CHUNK, CHUNK), CHUNK),
        'a_spatial_b': gain(ks[10], (N_A, N_MIX_HEADS, CHUNK)),
        'a_v_norm_g': gain(ks[11], (N_A, MIX_WIDTH)),
        'a_w_out': dense(ks[12], (N_A, A_OUT, D_MODEL), A_OUT),
        'b_w_in': dense(ks[13], (N_B, D_MODEL, B_IN), D_MODEL),
        'b_w_out': dense(ks[14], (N_B, B_OUT, D_MODEL), B_OUT),
        'c_w_in': dense(ks[15], (N_C, D_MODEL, C_IN), D_MODEL),
        'c_forget_bias': jax.random.uniform(ks[16], (N_C, N_MIX_HEADS), f32, 1.0, 5.0),
        'c_w_out': dense(ks[17], (N_C, C_OUT, D_MODEL), C_OUT),
    }


def reference(x, mem, positions, norm_g, mem_norm_g, w_mem_kv, ffn_w_gate_up, ffn_w_down,
              a_w_in, a_spatial_w, a_spatial_b, a_v_norm_g, a_w_out,
              b_w_in, b_w_out, c_w_in, c_forget_bias, c_w_out):
    cos, sin = rope_tables(positions)
    for i in range(DEPTH):
        kind, j = i % 3, i // 3
        g = norm_g[i]
        x = x + 0.5 * rms_norm(swiglu_ffn(rms_norm(x, g[0]), ffn_w_gate_up[i, 0], ffn_w_down[i, 0]), g[1])
        h = rms_norm(x, g[2])
        mem_n = rms_norm(mem, mem_norm_g[i])
        if kind == 0:
            y = mixer_a(h, mem_n, w_mem_kv[i], a_w_in[j], a_spatial_w[j], a_spatial_b[j],
                        a_v_norm_g[j], a_w_out[j])
        elif kind == 1:
            y = mixer_b(h, mem_n, w_mem_kv[i], cos, sin, b_w_in[j], b_w_out[j])
        else:
            y = mixer_c(h, mem_n, w_mem_kv[i], c_w_in[j], c_forget_bias[j], c_w_out[j])
        x = x + rms_norm(y, g[3])
        x = x + 0.5 * rms_norm(swiglu_ffn(rms_norm(x, g[4]), ffn_w_gate_up[i, 1], ffn_w_down[i, 1]), g[5])
    return x
```

```cpp
#include <hip/hip_runtime.h>
#include <hip/hip_cooperative_groups.h>
#include <cstdio>
#include <cstdint>
namespace cg = cooperative_groups;
#define DI __device__ __forceinline__
DI unsigned pk2(float lo, float hi) { typedef float f2_t __attribute__((ext_vector_type(2))); typedef __bf16 b2_t __attribute__((ext_vector_type(2))); f2_t v = {lo, hi}; b2_t b = __builtin_convertvector(v, b2_t); return __builtin_bit_cast(unsigned, b); }
DI float bflo(unsigned w) { return __uint_as_float(w << 16); }
DI float bfhi(unsigned w) { return __uint_as_float(w & 0xffff0000u); }
namespace pg8 {
#define PG8_LAS __attribute__((address_space(3)))
typedef unsigned short bf16_t;
typedef short bf16x8 __attribute__((ext_vector_type(8)));
typedef float f32x4 __attribute__((ext_vector_type(4)));
typedef unsigned u32x4 __attribute__((ext_vector_type(4)));
constexpr int BM = 256, BK = 64, HALF = 128, HTB = HALF * BK * 2  , STAGE_BYTES = 8 * HTB, NXCD = 8, WGM = 8;

__host__ __device__ __forceinline__ int lds_byte(int r, int c) { const int st = (r >> 4) * 2 + (c >> 5), rr = r & 15, cc = c & 31, ob = rr * 64 + cc * 2; return st * 1024 + (ob ^ (((ob >> 9) & 1) << 5)); }
__host__ __device__ __forceinline__ void stage_rc(int b, int& R, int& C) { const int st = b / 1024, sb = b % 1024, swz = sb ^ (((sb >> 9) & 1) << 5); R = (st >> 1) * 16 + swz / 64; C = (st & 1) * 32 + (swz % 64) / 2; }
__host__ __device__ __forceinline__ int perm32(int rho) { const int n = rho >> 4, i = rho & 15; return 8 * (i >> 2) + 4 * n + (i & 3); }

struct Unit { int pm, pn; };
struct Gemm { const bf16_t* A; const bf16_t* Bt; int M, N, K; };

struct StaticOrder {
    int nM, nN, nwg, G, c;
    __host__ __device__ void init(int M, int N, int G_, int c_) { nM = M / BM; nN = N / BM; nwg = nM * nN; G = G_; c = c_; }
    __host__ __device__ bool next(int i, Unit& u) const {
        const long L = (long)i * G + c; if (L >= nwg) return false;
        int wgid = (int)L; { const int q = nwg / NXCD, r = nwg % NXCD, xcd = wgid % NXCD, off = wgid / NXCD; wgid = (xcd < r ? xcd * (q + 1) : r * (q + 1) + (xcd - r) * q) + off; }
        const int nig = WGM * nN, gid = wgid / nig, fm = gid * WGM, gsz = (nM - fm) < WGM ? (nM - fm) : WGM;
        u.pm = fm + ((wgid % nig) % gsz); u.pn = (wgid % nig) / gsz; return true;
    }
    __device__ __forceinline__ void a_ready(const Unit&) const {}
    __device__ __forceinline__ void done(const Unit&) const {}
};

typedef unsigned u32x4e __attribute__((ext_vector_type(4)));
DI u32x4e pack8(const f32x4& a, const f32x4& b) { u32x4e w; w.x = pk2(a[0], a[1]); w.y = pk2(a[2], a[3]); w.z = pk2(b[0], b[1]); w.w = pk2(b[2], b[3]); return w; }
DI float silu_mul(float g, float u) { return g * u * __builtin_amdgcn_rcpf(1.0f + __builtin_amdgcn_exp2f(-1.4426950408889634f * g)); }
DI float gelu_tanh(float x) { const float z2 = 1.5957691216057308f * (x + 0.044715f * x * x * x); return x * __builtin_amdgcn_rcpf(1.0f + __builtin_amdgcn_exp2f(-1.4426950408889634f * z2)); }
struct EpiPlain { static constexpr bool PERM = true, AFTER_DRAIN = false; bf16_t* O; int ldc; int wrap;
    __device__ __forceinline__ void operator()(const f32x4 (&acc)[2][2][4][2], const Unit& u, int wr, int wc, int fr, int fq) const {
        const int row0 = u.pm * BM + wr * 64 + fr, col0 = (u.pn % wrap) * BM + wc * 32 + 8 * fq;
#pragma unroll
        for (int ai = 0; ai < 2; ++ai)
#pragma unroll
            for (int m = 0; m < 4; ++m) { bf16_t* rowp = O + (size_t)(row0 + ai * HALF + m * 16) * ldc + col0;
#pragma unroll
                for (int bj = 0; bj < 2; ++bj) *(u32x4e*)(rowp + bj * HALF) = pack8(acc[ai][bj][m][0], acc[ai][bj][m][1]); }
    }
};
struct EpiSwiglu { static constexpr bool PERM = true, AFTER_DRAIN = false; bf16_t* H; int ldc;
    __device__ __forceinline__ void operator()(const f32x4 (&acc)[2][2][4][2], const Unit& u, int wr, int wc, int fr, int fq) const {
        const int row0 = u.pm * BM + wr * 64 + fr, col0 = u.pn * HALF + wc * 32 + 8 * fq;
#pragma unroll
        for (int ai = 0; ai < 2; ++ai)
#pragma unroll
            for (int m = 0; m < 4; ++m) { f32x4 h0, h1;
#pragma unroll
                for (int j = 0; j < 4; ++j) { h0[j] = silu_mul(acc[ai][0][m][0][j], acc[ai][1][m][0][j]); h1[j] = silu_mul(acc[ai][0][m][1][j], acc[ai][1][m][1][j]); }
                *(u32x4e*)(H + (size_t)(row0 + ai * HALF + m * 16) * ldc + col0) = pack8(h0, h1); }
    }
};
struct EpiYss { static constexpr bool PERM = true, AFTER_DRAIN = false; bf16_t* Y; float* ssp;
    __device__ __forceinline__ void operator()(const f32x4 (&acc)[2][2][4][2], const Unit& u, int wr, int wc, int fr, int fq) const {
        const int row0 = u.pm * BM + wr * 64 + fr, col0 = u.pn * BM + wc * 32 + 8 * fq;
#pragma unroll
        for (int ai = 0; ai < 2; ++ai)
#pragma unroll
            for (int m = 0; m < 4; ++m) { const int row = row0 + ai * HALF + m * 16; float s = 0.f;
#pragma unroll
                for (int bj = 0; bj < 2; ++bj) { const f32x4 v0 = acc[ai][bj][m][0], v1 = acc[ai][bj][m][1];
                    s += (v0[0] * v0[0] + v0[1] * v0[1]) + (v0[2] * v0[2] + v0[3] * v0[3]) + (v1[0] * v1[0] + v1[1] * v1[1]) + (v1[2] * v1[2] + v1[3] * v1[3]);
                    *(u32x4e*)(Y + (size_t)row * 1024 + col0 + bj * HALF) = pack8(v0, v1); }
                s += __shfl_xor(s, 16); s += __shfl_xor(s, 32);
                if (fq == 0) ssp[(size_t)row * 16 + u.pn * 4 + wc] = s; }
    }
};
struct EpiInA { static constexpr bool PERM = true, AFTER_DRAIN = false; bf16_t* O; float* vst;
    __device__ __forceinline__ void operator()(const f32x4 (&acc)[2][2][4][2], const Unit& u, int wr, int wc, int fr, int fq) const {
        const int row0 = u.pm * BM + wr * 64 + fr, col0 = u.pn * BM + wc * 32 + 8 * fq; const bool act = u.pn < 6, st = u.pn >= 3 && u.pn < 6;
#pragma unroll
        for (int ai = 0; ai < 2; ++ai)
#pragma unroll
            for (int m = 0; m < 4; ++m) { const int row = row0 + ai * HALF + m * 16; float s1 = 0.f, s2 = 0.f;
#pragma unroll
                for (int bj = 0; bj < 2; ++bj) { f32x4 v0 = acc[ai][bj][m][0], v1 = acc[ai][bj][m][1];
                    if (act) {
#pragma unroll
                        for (int j = 0; j < 4; ++j) { v0[j] = gelu_tanh(v0[j]); v1[j] = gelu_tanh(v1[j]); } }
                    s1 += (v0[0] + v0[1]) + (v0[2] + v0[3]) + (v1[0] + v1[1]) + (v1[2] + v1[3]);
                    s2 += (v0[0] * v0[0] + v0[1] * v0[1]) + (v0[2] * v0[2] + v0[3] * v0[3]) + (v1[0] * v1[0] + v1[1] * v1[1]) + (v1[2] * v1[2] + v1[3] * v1[3]);
                    *(u32x4e*)(O + (size_t)row * 1792 + col0 + bj * HALF) = pack8(v0, v1); }
                if (st) { s1 += __shfl_xor(s1, 16); s1 += __shfl_xor(s1, 32); s2 += __shfl_xor(s2, 16); s2 += __shfl_xor(s2, 32);
                    if (fq == 0) { float* p = vst + ((size_t)row * 12 + (u.pn - 3) * 4 + wc) * 2; p[0] = s1; p[1] = s2; } } }
    }
};
struct EpiInB { static constexpr bool PERM = true, AFTER_DRAIN = false; bf16_t* O; const float* rc; const float* rs;
    __device__ __forceinline__ void operator()(const f32x4 (&acc)[2][2][4][2], const Unit& u, int wr, int wc, int fr, int fq) const {
        const int row0 = u.pm * BM + wr * 64 + fr;
        if (u.pn < 6) {
#pragma unroll
            for (int ai = 0; ai < 2; ++ai)
#pragma unroll
                for (int m = 0; m < 4; ++m) { const int row = row0 + ai * HALF + m * 16;
                    const f32x4 c0 = *(const f32x4*)(rc + (size_t)row * 32 + 8 * fq), c1 = *(const f32x4*)(rc + (size_t)row * 32 + 8 * fq + 4);
                    const f32x4 s0 = *(const f32x4*)(rs + (size_t)row * 32 + 8 * fq), s1 = *(const f32x4*)(rs + (size_t)row * 32 + 8 * fq + 4);
                    const f32x4 a0 = acc[ai][0][m][0], a1 = acc[ai][0][m][1], b0 = acc[ai][1][m][0], b1 = acc[ai][1][m][1];
                    const f32x4 o10 = a0 * c0 - b0 * s0, o11 = a1 * c1 - b1 * s1, o20 = b0 * c0 + a0 * s0, o21 = b1 * c1 + a1 * s1;
                    bf16_t* p = O + (size_t)row * 2560 + u.pn * BM + wc * 64 + 8 * fq;
                    *(u32x4e*)p = pack8(o10, o11); *(u32x4e*)(p + 32) = pack8(o20, o21); }
        } else {
            const int col0 = u.pn * BM + wc * 32 + 8 * fq;
#pragma unroll
            for (int ai = 0; ai < 2; ++ai)
#pragma unroll
                for (int m = 0; m < 4; ++m) { bf16_t* rowp = O + (size_t)(row0 + ai * HALF + m * 16) * 2560 + col0;
#pragma unroll
                    for (int bj = 0; bj < 2; ++bj) *(u32x4e*)(rowp + bj * HALF) = pack8(acc[ai][bj][m][0], acc[ai][bj][m][1]); }
        }
    }
};
struct EpiInC { static constexpr bool PERM = true, AFTER_DRAIN = false; bf16_t* O; float* logf_out; const float* fbias;
    __device__ __forceinline__ void operator()(const f32x4 (&acc)[2][2][4][2], const Unit& u, int wr, int wc, int fr, int fq) const {
        const int row0 = u.pm * BM + wr * 64 + fr;
        if (u.pn < 10) {
            const int col0 = u.pn * BM + wc * 32 + 8 * fq;
#pragma unroll
            for (int ai = 0; ai < 2; ++ai)
#pragma unroll
                for (int m = 0; m < 4; ++m) { bf16_t* rowp = O + (size_t)(row0 + ai * HALF + m * 16) * 2560 + col0;
#pragma unroll
                    for (int bj = 0; bj < 2; ++bj) *(u32x4e*)(rowp + bj * HALF) = pack8(acc[ai][bj][m][0], acc[ai][bj][m][1]); }
        } else if (wc == 0 && fq < 2) {
#pragma unroll
            for (int ai = 0; ai < 2; ++ai)
#pragma unroll
                for (int m = 0; m < 4; ++m) { const int row = row0 + ai * HALF + m * 16;
#pragma unroll
                    for (int n = 0; n < 2; ++n) { if (fq == 1 && n == 1) continue;
#pragma unroll
                        for (int j = 0; j < 4; ++j) { const int c = 8 * fq + 4 * n + j; const float z = acc[ai][0][m][n][j] + fbias[c];
                            logf_out[(size_t)row * 12 + c] = fminf(z, 0.f) - log1pf(expf(-fabsf(z))); } } }
        }
    }
};
struct MemKvOrder { int G, c;
    __device__ bool next(int i, Unit& u) const { const int L = i * G + c; if (L >= 64) return false; const int l = L >> 4, rem = L & 15; u.pm = l * 8 + (rem >> 1); u.pn = l * 2 + (rem & 1); return true; }
    __device__ __forceinline__ void a_ready(const Unit&) const {}
    __device__ __forceinline__ void done(const Unit&) const {}
};
template <class Epi, class Sched, bool ALIGN_EPI = false, bool SP2 = false>
__device__ __forceinline__ void gemm_phase(PG8_LAS unsigned char* lds, const Gemm g, const Sched& S, const Epi& E, const int tid) {
    const int wid = __builtin_amdgcn_readfirstlane(tid >> 6), lane = tid & 63, wr = wid >> 2, wc = wid & 3, fr = lane & 15, fq = lane >> 4;
    const int K = g.K, nt = K / BK;
    unsigned voffA[2], voffB[2];
#pragma unroll
    for (int i = 0; i < 2; ++i) { int R, C; stage_rc(tid * 16 + i * 8192, R, C); const int Rb = Epi::PERM ? ((R & ~31) + perm32(R & 31)) : R;
        voffA[i] = (unsigned)(R * K + C) * 2u; voffB[i] = (unsigned)(Rb * K + C) * 2u; }
    const size_t kstep = (size_t)(BK * 2);
    const size_t hstep = (size_t)HALF * K * 2;
    const size_t tstep = 2 * hstep;
    const unsigned ldsw = (unsigned)wid * 1024u;
    const int aoff = lds_byte(wr * 64 + fr, fq * 8), boff = lds_byte(wc * 32 + fr, fq * 8);
#define PG8_SA(b, h) (((b) * 2 + (h)) * HTB)
#define PG8_SB(b, h) ((4 + (b) * 2 + (h)) * HTB)
#define PG8_STAGE(bufoff, gbase, voff) do { _Pragma("unroll") for (int _i = 0; _i < 2; ++_i) \
        __builtin_amdgcn_global_load_lds((const unsigned*)((const char*)(gbase) + (voff)[_i]), (PG8_LAS unsigned*)(lds + (bufoff) + ldsw + _i * 8192), 16, 0, 0); } while (0)
#define PG8_LDA(dst, b, h) do { _Pragma("unroll") for (int m = 0; m < 4; ++m) _Pragma("unroll") for (int k = 0; k < 2; ++k) dst[m][k] = *(const PG8_LAS bf16x8*)(lds + PG8_SA(b, h) + aoff + m * 2048 + k * 1024); } while (0)
#define PG8_LDB(dst, b, h) do { _Pragma("unroll") for (int n = 0; n < 2; ++n) _Pragma("unroll") for (int k = 0; k < 2; ++k) dst[n][k] = *(const PG8_LAS bf16x8*)(lds + PG8_SB(b, h) + boff + n * 2048 + k * 1024); } while (0)
#define PG8_MMA(ai, bj, At, Bt) do { __builtin_amdgcn_s_setprio(1); _Pragma("unroll") for (int m = 0; m < 4; ++m) _Pragma("unroll") for (int n = 0; n < 2; ++n) _Pragma("unroll") for (int k = 0; k < 2; ++k) \
        acc[ai][bj][m][n] = __builtin_amdgcn_mfma_f32_16x16x32_bf16(Bt[n][k], At[m][k], acc[ai][bj][m][n], 0, 0, 0); __builtin_amdgcn_s_setprio(0); } while (0)
#define PG8_WAIT_V(n) asm volatile("s_waitcnt vmcnt(" #n ")" ::: "memory")
#define PG8_WAIT_L(n) asm volatile("s_waitcnt lgkmcnt(" #n ")" ::: "memory")
#define PG8_BAR __builtin_amdgcn_s_barrier()
#define PG8_SCHED __builtin_amdgcn_sched_barrier(0)
    Unit cur, nxt; int ui = 0;
    if (!S.next(0, cur)) return;
    f32x4 acc[2][2][4][2];
#pragma unroll
    for (int a = 0; a < 2; ++a)
#pragma unroll
        for (int b = 0; b < 2; ++b)
#pragma unroll
            for (int m = 0; m < 4; ++m)
#pragma unroll
                for (int n = 0; n < 2; ++n) acc[a][b][m][n] = (f32x4){0.f, 0.f, 0.f, 0.f};
    bf16x8 At[4][2], B0[2][2], B1[2][2];
    const char* cA = (const char*)g.A + (size_t)cur.pm * tstep; const char* cB = (const char*)g.Bt + (size_t)cur.pn * tstep;
    S.a_ready(cur);
    if constexpr (SP2) {
        PG8_STAGE(PG8_SB(0, 0), cB, voffB); PG8_STAGE(PG8_SB(0, 1), cB + hstep, voffB); PG8_STAGE(PG8_SA(0, 0), cA, voffA); PG8_STAGE(PG8_SA(0, 1), cA + hstep, voffA);
        if (wr == 1) PG8_BAR;
        PG8_WAIT_V(2); PG8_BAR;
        PG8_STAGE(PG8_SB(1, 0), cB + kstep, voffB); PG8_STAGE(PG8_SA(1, 0), cA + kstep, voffA); PG8_STAGE(PG8_SB(1, 1), cB + hstep + kstep, voffB);
        PG8_WAIT_V(6); PG8_BAR;
    } else {
        PG8_STAGE(PG8_SB(0, 0), cB, voffB); PG8_STAGE(PG8_SA(0, 0), cA, voffA); PG8_STAGE(PG8_SB(0, 1), cB + hstep, voffB); PG8_STAGE(PG8_SA(0, 1), cA + hstep, voffA);
        if (wr == 1) PG8_BAR;
        PG8_WAIT_V(4); PG8_BAR;
        PG8_STAGE(PG8_SB(1, 0), cB + kstep, voffB); PG8_STAGE(PG8_SA(1, 0), cA + kstep, voffA); PG8_STAGE(PG8_SB(1, 1), cB + hstep + kstep, voffB);
        PG8_WAIT_V(6); PG8_BAR;
    }
    for (;;) {
        const bool has_next = S.next(ui + 1, nxt);
        const char* nA = has_next ? (const char*)g.A + (size_t)nxt.pm * tstep : cA; const char* nB = has_next ? (const char*)g.Bt + (size_t)nxt.pn * tstep : cB;
        for (int t = 0; t < nt; t += 2) {
            const bool last = (t == nt - 2);
            const char* a1 = cA + (size_t)(t + 1) * kstep;
            const char* a2 = last ? nA : cA + (size_t)(t + 2) * kstep; const char* b2 = last ? nB : cB + (size_t)(t + 2) * kstep;
            const char* a3 = a2 + kstep; const char* b3 = b2 + kstep;
            if (last && has_next) S.a_ready(nxt);
            if constexpr (SP2) {
            PG8_LDB(B0, 0, 0); PG8_LDB(B1, 0, 1); PG8_SCHED; PG8_LDA(At, 0, 0); PG8_STAGE(PG8_SA(1, 1), a1 + hstep, voffA);
            PG8_WAIT_V(8); PG8_WAIT_L(0); PG8_BAR; PG8_MMA(0, 0, At, B0); PG8_MMA(0, 1, At, B1); PG8_BAR; PG8_SCHED;
            PG8_LDA(At, 0, 1); PG8_STAGE(PG8_SB(0, 0), b2, voffB); PG8_STAGE(PG8_SB(0, 1), b2 + hstep, voffB); PG8_STAGE(PG8_SA(0, 0), a2, voffA);
            PG8_WAIT_V(8); PG8_WAIT_L(0); PG8_BAR; PG8_MMA(1, 0, At, B0); PG8_MMA(1, 1, At, B1); PG8_BAR; PG8_SCHED;
            PG8_LDB(B0, 1, 0); PG8_LDB(B1, 1, 1); PG8_SCHED; PG8_LDA(At, 1, 0); PG8_STAGE(PG8_SA(0, 1), a2 + hstep, voffA);
            PG8_WAIT_V(8); PG8_WAIT_L(0); PG8_BAR; PG8_MMA(0, 0, At, B0); PG8_MMA(0, 1, At, B1); PG8_BAR; PG8_SCHED;
            PG8_LDA(At, 1, 1); PG8_STAGE(PG8_SB(1, 0), b3, voffB); PG8_STAGE(PG8_SB(1, 1), b3 + hstep, voffB); PG8_STAGE(PG8_SA(1, 0), a3, voffA);
            PG8_WAIT_V(8); PG8_WAIT_L(0); PG8_BAR; PG8_MMA(1, 0, At, B0); PG8_MMA(1, 1, At, B1); PG8_BAR; PG8_SCHED;
            } else {
            PG8_LDB(B0, 0, 0); PG8_SCHED; PG8_LDA(At, 0, 0); PG8_STAGE(PG8_SA(1, 1), a1 + hstep, voffA);
            PG8_WAIT_L(8); PG8_BAR; PG8_WAIT_L(0); PG8_MMA(0, 0, At, B0); PG8_BAR; PG8_SCHED;
            PG8_LDB(B1, 0, 1); PG8_STAGE(PG8_SB(0, 0), b2, voffB);
            PG8_BAR; PG8_WAIT_L(0); PG8_MMA(0, 1, At, B1); PG8_BAR;
            PG8_LDA(At, 0, 1); PG8_STAGE(PG8_SA(0, 0), a2, voffA);
            PG8_BAR; PG8_WAIT_L(0); PG8_MMA(1, 0, At, B0); PG8_BAR; PG8_SCHED;
            PG8_STAGE(PG8_SB(0, 1), b2 + hstep, voffB);
            PG8_WAIT_V(6); PG8_BAR; PG8_MMA(1, 1, At, B1); PG8_BAR;
            PG8_LDB(B0, 1, 0); PG8_SCHED; PG8_LDA(At, 1, 0); PG8_STAGE(PG8_SA(0, 1), a2 + hstep, voffA);
            PG8_WAIT_L(8); PG8_BAR; PG8_WAIT_L(0); PG8_MMA(0, 0, At, B0); PG8_BAR; PG8_SCHED;
            PG8_LDB(B1, 1, 1); PG8_STAGE(PG8_SB(1, 0), b3, voffB);
            PG8_BAR; PG8_WAIT_L(0); PG8_MMA(0, 1, At, B1); PG8_BAR;
            PG8_LDA(At, 1, 1); PG8_STAGE(PG8_SA(1, 0), a3, voffA);
            PG8_BAR; PG8_WAIT_L(0); PG8_MMA(1, 0, At, B0); PG8_BAR; PG8_SCHED;
            PG8_STAGE(PG8_SB(1, 1), b3 + hstep, voffB);
            PG8_WAIT_V(6); PG8_BAR; PG8_MMA(1, 1, At, B1); PG8_BAR;
            }
        }
        if constexpr (ALIGN_EPI) { if (wr == 0) PG8_BAR; }
        if constexpr (!Epi::AFTER_DRAIN) { E(acc, cur, wr, wc, fr, fq); S.done(cur); }
        if (!has_next) break;
#pragma unroll
        for (int a = 0; a < 2; ++a)
#pragma unroll
            for (int b = 0; b < 2; ++b)
#pragma unroll
                for (int m = 0; m < 4; ++m)
#pragma unroll
                    for (int n = 0; n < 2; ++n) acc[a][b][m][n] = (f32x4){0.f, 0.f, 0.f, 0.f};
        cur = nxt; cA = nA; cB = nB; ++ui;
        if constexpr (ALIGN_EPI) { if (wr == 1) PG8_BAR; }
    }
    PG8_WAIT_V(0);
    if constexpr (!ALIGN_EPI) { if (wr == 0) PG8_BAR; }
    PG8_BAR;
    if constexpr (Epi::AFTER_DRAIN) { E.fused(acc, cur, wr, wc, fr, fq, lds, wid, lane); S.done(cur); }
#undef PG8_SA
#undef PG8_SB
#undef PG8_STAGE
#undef PG8_LDA
#undef PG8_LDB
#undef PG8_MMA
#undef PG8_WAIT_V
#undef PG8_WAIT_L
#undef PG8_BAR
#undef PG8_SCHED
}
}
#define LAS __attribute__((address_space(3)))
typedef unsigned short bf16;
typedef float f32x4 __attribute__((ext_vector_type(4)));
typedef float f32x16 __attribute__((ext_vector_type(16)));
typedef unsigned u32x4 __attribute__((ext_vector_type(4)));
typedef unsigned u32x2 __attribute__((ext_vector_type(2)));
typedef short bf16x8 __attribute__((ext_vector_type(8)));
typedef short s16x4 __attribute__((ext_vector_type(4)));
constexpr int NB = 8, SEQ = 4096, D = 1024, M = NB * SEQ, FF = 2816, NGU = 2 * FF, NMEM = 256, DEPTH = 4;
constexpr float RMS_EPS = 1e-6f, LN_EPS = 1e-5f, LOG2E = 1.4426950408889634f, LN2 = 0.6931471805599453f;
constexpr float C2 = 0.125f * LOG2E;
constexpr size_t MiB = 1u << 20;
constexpr size_t WS_WGU = 1 * MiB;
constexpr size_t WS_WD = WS_WGU + 88 * MiB;
constexpr size_t WS_WINA = WS_WD + 44 * MiB;
constexpr size_t WS_WINB = WS_WINA + 7 * MiB;
constexpr size_t WS_WINC = WS_WINB + 5 * MiB;
constexpr size_t WS_WOUTA = WS_WINC + 6 * MiB;
constexpr size_t WS_WOUTB = WS_WOUTA + 4 * MiB;
constexpr size_t WS_WOUTC = WS_WOUTB + 1 * MiB;
constexpr size_t WS_WMKV = WS_WOUTC + 2 * MiB;
constexpr size_t WS_SW = WS_WMKV + 4 * MiB;
constexpr size_t WS_MEMN = WS_SW + 1 * MiB;
constexpr size_t WS_MKV = WS_MEMN + 16 * MiB;
constexpr size_t WS_RC = WS_MKV + 8 * MiB;
constexpr size_t WS_RS = WS_RC + 4 * MiB;
constexpr size_t WS_SSP = WS_RS + 4 * MiB;
constexpr size_t WS_VST = WS_SSP + 2 * MiB;
constexpr size_t WS_LOGF = WS_VST + 3 * MiB;
constexpr size_t WS_NEGC = WS_LOGF + 2 * MiB;
constexpr size_t WS_LSE = WS_NEGC + 2 * MiB;
constexpr size_t WS_XN = WS_LSE + 2 * MiB;
constexpr size_t WS_Y = WS_XN + 64 * MiB;
constexpr size_t WS_YO = WS_Y + 64 * MiB;
constexpr size_t WS_OB = WS_YO + 64 * MiB;
constexpr size_t WS_HP = WS_OB + 48 * MiB;
constexpr size_t WS_END = WS_HP + 176 * MiB;
constexpr int LDS_BYTES = 147456;

struct Args { const void* in[18]; float* out; unsigned char* ws; int ph_lo, ph_hi; };

DI const void* launder_s(const void* p) { asm volatile("" : "+s"(p)); return p; }
DI float wave_sum(float v) {
#pragma unroll
    for (int o = 1; o < 64; o <<= 1) v += __shfl_xor(v, o);
    return v;
}
DI int src_col(int mode, int n) {
    if (mode == 1) { const int t = n >> 8, j = n & 255; return j < 128 ? 128 * t + j : FF + 128 * t + (j - 128); }
    if (mode == 2) { if (n >= 1536) return n; const int t = n >> 8, j = n & 255, half = j >> 7, p = j & 127, hd = p >> 5, d = p & 31; return 256 * t + hd * 64 + half * 32 + d; }
    if (mode == 3) { if (n < 2304) return n; if (n < 2560) return n + 12; if (n < 2572) return n - 2560 + 2304; return -1; }
    return n;
}
DI void transpose_item(const float* W, int K, int Nsrc, bf16* WT, int Nout, int mode, LAS float* scr, int item, int lane) {
    const int nblk = Nout / 32, kb = item / nblk, nb = item % nblk, k0 = 64 * kb, n0 = 32 * nb;
    const int sc = src_col(mode, n0 + (lane & 31));
#pragma unroll 8
    for (int i = 0; i < 32; ++i) { const int kk = 2 * i + (lane >> 5); scr[kk * 33 + (lane & 31)] = sc >= 0 ? W[(size_t)(k0 + kk) * Nsrc + sc] : 0.f; }
    asm volatile("s_waitcnt lgkmcnt(0)" ::: "memory");
    const int c = lane & 7;
#pragma unroll
    for (int j = 0; j < 4; ++j) { const int n = (lane >> 3) + 8 * j; const LAS float* s = scr + (8 * c) * 33 + n;
        u32x4 o; o.x = pk2(s[0 * 33], s[1 * 33]); o.y = pk2(s[2 * 33], s[3 * 33]); o.z = pk2(s[4 * 33], s[5 * 33]); o.w = pk2(s[6 * 33], s[7 * 33]);
        *(u32x4*)(WT + (size_t)(n0 + n) * K + k0 + 8 * c) = o; }
    asm volatile("s_waitcnt lgkmcnt(0)" ::: "memory");
}
DI void rms_store(const f32x4 (&v)[4], const float* g, bf16* orow, int lane) {
    float s2 = 0.f;
#pragma unroll
    for (int j = 0; j < 4; ++j) s2 += (v[j][0] * v[j][0] + v[j][1] * v[j][1]) + (v[j][2] * v[j][2] + v[j][3] * v[j][3]);
    const float rs = 1.0f / sqrtf(wave_sum(s2) * (1.0f / D) + RMS_EPS);
#pragma unroll
    for (int j = 0; j < 4; ++j) { const f32x4 gg = *(const f32x4*)(g + 4 * lane + 256 * j); const f32x4 o = v[j] * rs * gg;
        u32x2 w; w.x = pk2(o[0], o[1]); w.y = pk2(o[2], o[3]); *(u32x2*)(orow + 4 * lane + 256 * j) = w; }
}
DI void norm_pass(const float* xin, const bf16* yo, const float* ssp, const float* gpost, float scale, float* xout, const float* gnext, bf16* xn, int gw, int ngw, int lane) {
    for (int row = gw; row < M; row += ngw) {
        f32x4 v[4];
#pragma unroll
        for (int j = 0; j < 4; ++j) v[j] = *(const f32x4*)(xin + (size_t)row * D + 4 * lane + 256 * j);
        const float part = lane < 16 ? ssp[(size_t)row * 16 + lane] : 0.f;
        const float r = scale / sqrtf(wave_sum(part) * (1.0f / D) + RMS_EPS);
#pragma unroll
        for (int j = 0; j < 4; ++j) { const u32x2 y = *(const u32x2*)(yo + (size_t)row * D + 4 * lane + 256 * j); const f32x4 gg = *(const f32x4*)(gpost + 4 * lane + 256 * j);
            f32x4 yy; yy[0] = bflo(y.x); yy[1] = bfhi(y.x); yy[2] = bflo(y.y); yy[3] = bfhi(y.y);
            v[j] = v[j] + yy * r * gg; *(f32x4*)(xout + (size_t)row * D + 4 * lane + 256 * j) = v[j]; }
        if (gnext) rms_store(v, gnext, xn + (size_t)row * D, lane);
    }
}
#define MFMA32(a, b, c) __builtin_amdgcn_mfma_f32_32x32x16_bf16((a), (b), (c), 0, 0, 0)
constexpr int TROW = 144;
constexpr int TB = 64 * TROW;
DI s16x4 trd(const LAS unsigned char* p) { return __builtin_bit_cast(s16x4, __builtin_amdgcn_ds_read_tr16_b64_v4i16((LAS s16x4*)p)); }
DI bf16x8 vfrag(const LAS unsigned char* p) { const s16x4 lo = trd(p), hi = trd(p + 8 * TROW); return __builtin_shufflevector(lo, hi, 0, 1, 2, 3, 4, 5, 6, 7); }
template <int S> DI bf16x8 packp(const f32x16& x) { u32x4 w; w.x = pk2(x[8 * S], x[8 * S + 1]); w.y = pk2(x[8 * S + 2], x[8 * S + 3]); w.z = pk2(x[8 * S + 4], x[8 * S + 5]); w.w = pk2(x[8 * S + 6], x[8 * S + 7]); return __builtin_bit_cast(bf16x8, w); }
struct AttnJob { const bf16* Q; const bf16* K; const bf16* V; bf16* O; float* lse; const float* kbias; long qs, ks, vs, os, ls; int kt_lo, kt_hi, mode, q_off; };
DI void attn_unit(const AttnJob& J, LAS unsigned char* lds, int tid, int wid, int lane) {
    const int r = lane & 31, h = lane >> 5;
    bf16x8 qr[4];
    { const bf16* qp = J.Q + (long)(32 * wid + r) * J.qs + 8 * h;
#pragma unroll
      for (int ds = 0; ds < 4; ++ds) qr[ds] = *(const bf16x8*)(qp + 16 * ds); }
    float m = -1e30f, l = 0.f; f32x16 o0, o1;
#pragma unroll
    for (int i = 0; i < 16; ++i) { o0[i] = 0.f; o1[i] = 0.f; }
    const int qa0 = J.q_off + 32 * wid, qa = qa0 + r;
    const int srow = tid >> 3, sch = tid & 7;
    const bf16* kp = J.K + (long)srow * J.ks + 8 * sch; const bf16* vp = J.V + (long)srow * J.vs + 8 * sch;
    const int voff = (4 * h + ((lane & 15) >> 2)) * TROW + ((lane >> 4) & 1) * 32 + (lane & 3) * 8;
    u32x4 kreg = *(const u32x4*)(kp + (long)J.kt_lo * 64 * J.ks), vreg = *(const u32x4*)(vp + (long)J.kt_lo * 64 * J.vs);
    int cur = 0;
    for (int kt = J.kt_lo; kt < J.kt_hi; ++kt) {
        LAS unsigned char* kb = lds + cur * TB; LAS unsigned char* vb = lds + 2 * TB + cur * TB;
        *(LAS u32x4*)(kb + srow * TROW + sch * 16) = kreg; *(LAS u32x4*)(vb + srow * TROW + sch * 16) = vreg;
        __syncthreads();
        if (kt + 1 < J.kt_hi) { kreg = *(const u32x4*)(kp + (long)(kt + 1) * 64 * J.ks); vreg = *(const u32x4*)(vp + (long)(kt + 1) * 64 * J.vs); }
        const int k0 = 64 * kt;
        bool skip = false, need_mask = false;
        if (J.mode == 1) { skip = k0 > qa0 + 31; need_mask = k0 + 63 > qa0; }
        else if (J.mode == 2) { skip = (k0 > qa0 + 31) || (k0 + 63 < qa0 - 128); need_mask = !((k0 + 63 <= qa0) && (qa0 + 31 - k0 <= 128)); }
        if (!skip) {
            f32x16 p0, p1;
#pragma unroll
            for (int i = 0; i < 16; ++i) { p0[i] = 0.f; p1[i] = 0.f; }
#pragma unroll
            for (int ds = 0; ds < 4; ++ds) { const bf16x8 a0 = *(const LAS bf16x8*)(kb + r * TROW + 32 * ds + 16 * h), a1 = *(const LAS bf16x8*)(kb + (32 + r) * TROW + 32 * ds + 16 * h);
                p0 = MFMA32(a0, qr[ds], p0); p1 = MFMA32(a1, qr[ds], p1); }
#pragma unroll
            for (int g = 0; g < 4; ++g) { f32x4 b0 = {0.f, 0.f, 0.f, 0.f}, b1 = {0.f, 0.f, 0.f, 0.f};
                if (J.kbias) { b0 = *(const f32x4*)(J.kbias + k0 + 8 * g + 4 * h); b1 = *(const f32x4*)(J.kbias + k0 + 32 + 8 * g + 4 * h); }
#pragma unroll
                for (int j = 0; j < 4; ++j) { p0[4 * g + j] = __builtin_fmaf(p0[4 * g + j], C2, b0[j]); p1[4 * g + j] = __builtin_fmaf(p1[4 * g + j], C2, b1[j]); } }
            if (need_mask) {
#pragma unroll
                for (int i = 0; i < 16; ++i) { const int ka = k0 + (i & 3) + 8 * (i >> 2) + 4 * h, kb2 = ka + 32;
                    const bool bad0 = J.mode == 1 ? (ka > qa) : (ka > qa || qa - ka > 128), bad1 = J.mode == 1 ? (kb2 > qa) : (kb2 > qa || qa - kb2 > 128);
                    if (bad0) p0[i] = -INFINITY; if (bad1) p1[i] = -INFINITY; } }
            float mx = fmaxf(p0[0], p1[0]);
#pragma unroll
            for (int i = 1; i < 16; ++i) mx = fmaxf(mx, fmaxf(p0[i], p1[i]));
            mx = fmaxf(mx, __shfl_xor(mx, 32));
            const float mn = fmaxf(m, mx), alpha = __builtin_amdgcn_exp2f(m - mn); m = mn;
            float ps = 0.f;
#pragma unroll
            for (int i = 0; i < 16; ++i) { p0[i] = __builtin_amdgcn_exp2f(p0[i] - mn); p1[i] = __builtin_amdgcn_exp2f(p1[i] - mn); ps += p0[i] + p1[i]; }
            l = l * alpha + ps;
#pragma unroll
            for (int i = 0; i < 16; ++i) { o0[i] *= alpha; o1[i] *= alpha; }
            const LAS unsigned char* vl = vb + voff;
            { const bf16x8 b = packp<0>(p0); o0 = MFMA32(vfrag(vl), b, o0); o1 = MFMA32(vfrag(vl + 64), b, o1); }
            { const bf16x8 b = packp<1>(p0); o0 = MFMA32(vfrag(vl + 16 * TROW), b, o0); o1 = MFMA32(vfrag(vl + 16 * TROW + 64), b, o1); }
            { const bf16x8 b = packp<0>(p1); o0 = MFMA32(vfrag(vl + 32 * TROW), b, o0); o1 = MFMA32(vfrag(vl + 32 * TROW + 64), b, o1); }
            { const bf16x8 b = packp<1>(p1); o0 = MFMA32(vfrag(vl + 48 * TROW), b, o0); o1 = MFMA32(vfrag(vl + 48 * TROW + 64), b, o1); }
        }
        cur ^= 1;
    }
    l += __shfl_xor(l, 32);
    const float inv = 1.0f / l;
    bf16* op = J.O + (long)(32 * wid + r) * J.os + 4 * h;
#pragma unroll
    for (int g = 0; g < 4; ++g) { u32x2 w0, w1; w0.x = pk2(o0[4 * g] * inv, o0[4 * g + 1] * inv); w0.y = pk2(o0[4 * g + 2] * inv, o0[4 * g + 3] * inv);
        w1.x = pk2(o1[4 * g] * inv, o1[4 * g + 1] * inv); w1.y = pk2(o1[4 * g + 2] * inv, o1[4 * g + 3] * inv);
        *(u32x2*)(op + 8 * g) = w0; *(u32x2*)(op + 32 + 8 * g) = w1; }
    if (J.lse && h == 0) J.lse[(long)(32 * wid + r) * J.ls] = (m + __builtin_amdgcn_logf(l)) * LN2;
    __syncthreads();
}
DI AttnJob mem_job(int u, const bf16* P, int ldp, int qmoff, const bf16* mkv, bf16* Y, int ldy, int yoff) {
    const int b = u >> 6, mh = (u >> 4) & 3, qb = u & 15; AttnJob J;
    J.Q = P + (size_t)(b * SEQ + 256 * qb) * ldp + qmoff + mh * 64; J.qs = ldp;
    J.K = mkv + (size_t)(b * NMEM) * 512 + mh * 64; J.ks = 512; J.V = J.K + 256; J.vs = 512;
    J.O = Y + (size_t)(b * SEQ + 256 * qb) * ldy + yoff + mh * 64; J.os = ldy; J.lse = nullptr; J.ls = 0; J.kbias = nullptr;
    J.kt_lo = 0; J.kt_hi = 4; J.mode = 0; J.q_off = 0; return J;
}
DI void gmlp_unit(int b, int cp, int g, const bf16* P, const float* vst, const float* vg, const bf16* SWj, const float* sb, bf16* Y, LAS unsigned char* lds, int tid, int wid, int lane) {
    typedef float f32x2 __attribute__((ext_vector_type(2)));
    const int R0 = b * SEQ + cp * 256; const int r = lane & 31, h = lane >> 5;
    LAS f32x2* st = (LAS f32x2*)(lds + 256 * TROW);
    if (tid < 256) { const float* p = vst + (size_t)(R0 + tid) * 24; float s1 = 0.f, s2 = 0.f;
#pragma unroll
        for (int k = 0; k < 6; ++k) { const f32x4 t = *(const f32x4*)(p + 4 * k); s1 += t[0] + t[2]; s2 += t[1] + t[3]; }
        const float mean = s1 * (1.0f / 768.0f), var = s2 * (1.0f / 768.0f) - mean * mean; st[tid] = (f32x2){mean, 1.0f / sqrtf(var + LN_EPS)}; }
    __syncthreads();
#pragma unroll
    for (int k = 0; k < 4; ++k) { const int item = tid + 512 * k, row = item >> 3, ch = item & 7;
        const u32x4 raw = *(const u32x4*)(P + (size_t)(R0 + row) * 1792 + 768 + g * 64 + 8 * ch); const f32x2 ms = st[row];
        const f32x4 g0 = *(const f32x4*)(vg + g * 64 + 8 * ch), g1 = *(const f32x4*)(vg + g * 64 + 8 * ch + 4);
        u32x4 w; w.x = pk2((bflo(raw.x) - ms.x) * ms.y * g0[0], (bfhi(raw.x) - ms.x) * ms.y * g0[1]); w.y = pk2((bflo(raw.y) - ms.x) * ms.y * g0[2], (bfhi(raw.y) - ms.x) * ms.y * g0[3]);
        w.z = pk2((bflo(raw.z) - ms.x) * ms.y * g1[0], (bfhi(raw.z) - ms.x) * ms.y * g1[1]); w.w = pk2((bflo(raw.w) - ms.x) * ms.y * g1[2], (bfhi(raw.w) - ms.x) * ms.y * g1[3]);
        *(LAS u32x4*)(lds + row * TROW + ch * 16) = w; }
    __syncthreads();
    const int cl = wid >> 2, tb = wid & 3, t = 32 * tb + r;
    f32x16 o0, o1;
#pragma unroll
    for (int i = 0; i < 16; ++i) { o0[i] = 0.f; o1[i] = 0.f; }
    const bf16* wrow = SWj + ((size_t)g * 128 + t) * 128;
    const int voff = (4 * h + ((lane & 15) >> 2)) * TROW + ((lane >> 4) & 1) * 32 + (lane & 3) * 8;
    const int nsteps = 2 * (tb + 1);
    for (int s = 0; s < nsteps; ++s) {
        const s16x4 lo = *(const s16x4*)(wrow + 16 * s + 4 * h), hi = *(const s16x4*)(wrow + 16 * s + 8 + 4 * h);
        const bf16x8 bfr = __builtin_shufflevector(lo, hi, 0, 1, 2, 3, 4, 5, 6, 7);
        const LAS unsigned char* vl = lds + (128 * cl + 16 * s) * TROW + voff;
        o0 = MFMA32(vfrag(vl), bfr, o0); o1 = MFMA32(vfrag(vl + 64), bfr, o1);
    }
    const size_t row = (size_t)R0 + 128 * cl + t; const float bias = sb[g * 128 + t];
    const bf16* up = P + row * 1792 + g * 64 + 4 * h; bf16* yp = Y + row * 1024 + g * 64 + 4 * h;
#pragma unroll
    for (int q = 0; q < 4; ++q) { const u32x2 u0 = *(const u32x2*)(up + 8 * q), u1 = *(const u32x2*)(up + 32 + 8 * q); u32x2 w0, w1;
        w0.x = pk2((o0[4 * q] + bias) * bflo(u0.x), (o0[4 * q + 1] + bias) * bfhi(u0.x)); w0.y = pk2((o0[4 * q + 2] + bias) * bflo(u0.y), (o0[4 * q + 3] + bias) * bfhi(u0.y));
        w1.x = pk2((o1[4 * q] + bias) * bflo(u1.x), (o1[4 * q + 1] + bias) * bfhi(u1.x)); w1.y = pk2((o1[4 * q + 2] + bias) * bflo(u1.y), (o1[4 * q + 3] + bias) * bfhi(u1.y));
        *(u32x2*)(yp + 8 * q) = w0; *(u32x2*)(yp + 32 + 8 * q) = w1; }
    __syncthreads();
}
__global__ void __launch_bounds__(512, 2) mega_fwd(Args a) {
    extern __shared__ __attribute__((aligned(16))) unsigned char lds_raw[];
    LAS unsigned char* lds = (LAS unsigned char*)lds_raw;
    cg::grid_group grid = cg::this_grid();
#define INP(T, k) ((const T*)launder_s(a.in[k]))
#define x_in INP(float, 0)
#define mem INP(float, 1)
#define pos INP(int, 2)
#define norm_g INP(float, 3)
#define mem_g INP(float, 4)
#define xres ((float*)launder_s(a.out))
#define WSP(T, off) ((T*)(wsb + (off)))
#define WGU WSP(bf16, WS_WGU)
#define WD WSP(bf16, WS_WD)
#define WINA WSP(bf16, WS_WINA)
#define WINB WSP(bf16, WS_WINB)
#define WINC WSP(bf16, WS_WINC)
#define WOUTA WSP(bf16, WS_WOUTA)
#define WOUTB WSP(bf16, WS_WOUTB)
#define WOUTC WSP(bf16, WS_WOUTC)
#define WMKV WSP(bf16, WS_WMKV)
#define SW WSP(bf16, WS_SW)
#define MEMN WSP(bf16, WS_MEMN)
#define MKV WSP(bf16, WS_MKV)
#define RC WSP(float, WS_RC)
#define RS WSP(float, WS_RS)
#define SSP WSP(float, WS_SSP)
#define VST WSP(float, WS_VST)
#define LOGF WSP(float, WS_LOGF)
#define NEGC WSP(float, WS_NEGC)
#define LSE WSP(float, WS_LSE)
#define XN WSP(bf16, WS_XN)
#define Y WSP(bf16, WS_Y)
#define YO WSP(bf16, WS_YO)
#define OB WSP(bf16, WS_OB)
#define HP WSP(bf16, WS_HP)
    const int ph_end = a.ph_hi < 1 + 12 * DEPTH ? a.ph_hi : 1 + 12 * DEPTH;
    for (int ph = a.ph_lo; ph < ph_end; ++ph) {
        int tid = threadIdx.x; asm volatile("" : "+v"(tid));
        const int lane = tid & 63, wid = __builtin_amdgcn_readfirstlane(tid >> 6);
        int G = gridDim.x, bx = blockIdx.x; asm volatile("" : "+s"(G), "+s"(bx));
        const int gw = bx * 8 + wid, ngw = G * 8;
        unsigned char* wsb = a.ws; asm volatile("" : "+s"(wsb));
        const int layer = ph == 0 ? 0 : (ph - 1) / 12, slot = ph == 0 ? -1 : (ph - 1) % 12, kind = layer % 3, jx = layer / 3;
        if ((slot == 4 && kind != 2) || (slot == 6 && kind != 1)) continue;
        const int f = slot >= 9 ? 1 : 0;
        if (ph == 0) {
            LAS float* scr = (LAS float*)(lds + wid * 16384);
            int base = 0;
            for (int j = 0; j < 28; ++j) {
                const float* W; bf16* WT; int K, Nsrc, Nout, mode = 0;
                if (j < 8) { W = INP(float, 6) + (size_t)j * D * NGU; WT = WGU + (size_t)j * NGU * D; K = D; Nsrc = NGU; Nout = NGU; mode = 1; }
                else if (j < 16) { W = INP(float, 7) + (size_t)(j - 8) * FF * D; WT = WD + (size_t)(j - 8) * D * FF; K = FF; Nsrc = D; Nout = D; }
                else if (j < 18) { W = INP(float, 8) + (size_t)(j - 16) * D * 1792; WT = WINA + (size_t)(j - 16) * 1792 * D; K = D; Nsrc = 1792; Nout = 1792; }
                else if (j == 18) { W = INP(float, 13); WT = WINB; K = D; Nsrc = 2560; Nout = 2560; mode = 2; }
                else if (j == 19) { W = INP(float, 15); WT = WINC; K = D; Nsrc = 2572; Nout = 2816; mode = 3; }
                else if (j < 22) { W = INP(float, 12) + (size_t)(j - 20) * D * D; WT = WOUTA + (size_t)(j - 20) * D * D; K = D; Nsrc = D; Nout = D; }
                else if (j == 22) { W = INP(float, 14); WT = WOUTB; K = 512; Nsrc = D; Nout = D; }
                else if (j == 23) { W = INP(float, 17); WT = WOUTC; K = D; Nsrc = D; Nout = D; }
                else { W = INP(float, 5) + (size_t)(j - 24) * D * 512; WT = WMKV + (size_t)(j - 24) * 512 * D; K = D; Nsrc = 512; Nout = 512; }
                const int nitems = (K / 64) * (Nout / 32);
                for (int it = (gw + ngw - (base % ngw)) % ngw; it < nitems; it += ngw) transpose_item(W, K, Nsrc, WT, Nout, mode, scr, it, lane);
                base += nitems;
            }
            { const float* sw = INP(float, 9); const int n = 2 * 12 * 128 * 128;
              for (int i = bx * 512 + tid; i < n; i += G * 512) { const int t = (i >> 7) & 127, s = i & 127; const float v = s <= t ? sw[i] : 0.f; SW[i] = (bf16)(pk2(v, 0.f) & 0xffffu); } }
            for (int i = bx * 512 + tid; i < M * 32; i += G * 512) { const int row = i >> 5, k = i & 31; const float inv = powf(10000.0f, -(float)(2 * k) / 64.0f); const float ang = (float)pos[row] * inv; RC[i] = cosf(ang); RS[i] = sinf(ang); }
            for (int row = gw; row < NB * NMEM; row += ngw) { f32x4 v[4];
#pragma unroll
                for (int j = 0; j < 4; ++j) v[j] = *(const f32x4*)(mem + (size_t)row * D + 4 * lane + 256 * j);
                for (int l = 0; l < DEPTH; ++l) rms_store(v, mem_g + l * D, MEMN + ((size_t)l * NB * NMEM + row) * D, lane); }
            for (int row = gw; row < M; row += ngw) { f32x4 v[4];
#pragma unroll
                for (int j = 0; j < 4; ++j) v[j] = *(const f32x4*)(x_in + (size_t)row * D + 4 * lane + 256 * j);
                rms_store(v, norm_g, XN + (size_t)row * D, lane); }
        } else if (slot == 0 || slot == 9) {
            if (ph == 1) { pg8::Gemm g{MEMN, WMKV, DEPTH * NB * NMEM, DEPTH * 512, D}; pg8::MemKvOrder S{G, bx}; pg8::EpiPlain E{MKV, 512, 2};
                pg8::gemm_phase<pg8::EpiPlain, pg8::MemKvOrder, true, true>(lds, g, S, E, tid); }
            pg8::Gemm g{XN, WGU + (size_t)(layer * 2 + f) * NGU * D, M, NGU, D}; pg8::StaticOrder S; S.init(M, NGU, G, bx); pg8::EpiSwiglu E{HP, FF};
            pg8::gemm_phase<pg8::EpiSwiglu, pg8::StaticOrder, true, true>(lds, g, S, E, tid);
        } else if (slot == 1 || slot == 10 || slot == 7) {
            pg8::Gemm g;
            if (slot == 7) { g.A = Y; g.Bt = kind == 0 ? WOUTA + (size_t)jx * D * D : (kind == 1 ? WOUTB : WOUTC); g.K = kind == 1 ? 512 : D; }
            else { g.A = HP; g.Bt = WD + (size_t)(layer * 2 + f) * D * FF; g.K = FF; }
            g.M = M; g.N = D;
            pg8::StaticOrder S; S.init(M, D, G, bx); pg8::EpiYss E{YO, SSP};
            pg8::gemm_phase<pg8::EpiYss, pg8::StaticOrder, true, true>(lds, g, S, E, tid);
        } else if (slot == 2 || slot == 11 || slot == 8) {
            const float* g6 = norm_g + (size_t)layer * 6 * D;
            if (slot == 8) norm_pass(xres, YO, SSP, g6 + 3 * D, 1.0f, xres, g6 + 4 * D, XN, gw, ngw, lane);
            else { const float* xin = ph == 3 ? x_in : xres; const float* gnext = slot == 2 ? g6 + 2 * D : (layer + 1 < DEPTH ? g6 + 6 * D : nullptr);
                norm_pass(xin, YO, SSP, g6 + (slot == 2 ? 1 : 5) * D, 0.5f, xres, gnext, XN, gw, ngw, lane); }
        } else if (slot == 3) {
            if (kind == 0) { pg8::Gemm g{XN, WINA + (size_t)jx * 1792 * D, M, 1792, D}; pg8::StaticOrder S; S.init(M, 1792, G, bx); pg8::EpiInA E{HP, VST};
                pg8::gemm_phase<pg8::EpiInA, pg8::StaticOrder, true, true>(lds, g, S, E, tid); }
            else if (kind == 1) { pg8::Gemm g{XN, WINB, M, 2560, D}; pg8::StaticOrder S; S.init(M, 2560, G, bx); pg8::EpiInB E{HP, RC, RS};
                pg8::gemm_phase<pg8::EpiInB, pg8::StaticOrder, true, true>(lds, g, S, E, tid); }
            else { pg8::Gemm g{XN, WINC, M, 2816, D}; pg8::StaticOrder S; S.init(M, 2816, G, bx); pg8::EpiInC E{HP, LOGF, INP(float, 16)};
                pg8::gemm_phase<pg8::EpiInC, pg8::StaticOrder, true, true>(lds, g, S, E, tid); }
        } else if (slot == 4) {
            if (gw < NB * 12) { const int b = gw / 12, hh = gw % 12; const float* lf = LOGF + (size_t)b * SEQ * 12 + hh; float s = 0.f;
                for (int t = 0; t < 64; ++t) s += lf[(size_t)(64 * lane + t) * 12];
                float inc = s;
#pragma unroll
                for (int o = 1; o < 64; o <<= 1) { const float t = __shfl_up(inc, o); if (lane >= o) inc += t; }
                float run = inc - s;
                for (int t = 0; t < 64; ++t) { run += lf[(size_t)(64 * lane + t) * 12]; NEGC[(size_t)gw * SEQ + 64 * lane + t] = -run * LOG2E; } }
        } else if (slot == 5) {
            const bf16* mkv = MKV + (size_t)layer * NB * NMEM * 512;
            if (kind == 0) {
                for (int u = bx; u < 2048; u += G) {
                    if (u < 1536) { const int b = u / 192, rem = u % 192; gmlp_unit(b, rem / 12, rem % 12, HP, VST, INP(float, 11) + jx * 768, SW + (size_t)jx * 12 * 128 * 128, INP(float, 10) + jx * 12 * 128, Y, lds, tid, wid, lane); }
                    else { const AttnJob J = mem_job(u - 1536, HP, 1792, 1536, mkv, Y, 1024, 768); attn_unit(J, lds, tid, wid, lane); }
                }
            } else if (kind == 1) {
                for (int u = bx; u < 2048; u += G) {
                    AttnJob J;
                    if (u < 1536) { const int b = u / 192, rem = u % 192, hd = rem >> 4, w16 = rem & 15, grp = hd >> 2, dil = 1 << (2 * grp), upr = 16 >> (2 * grp), res = w16 / upr, mm = w16 % upr;
                        const size_t brow = (size_t)b * SEQ + res;
                        J.Q = HP + (brow + (size_t)256 * mm * dil) * 2560 + hd * 64; J.qs = (long)dil * 2560;
                        J.K = HP + brow * 2560 + 768 + hd * 64; J.ks = (long)dil * 2560; J.V = J.K + 768; J.vs = J.ks;
                        J.O = OB + (brow + (size_t)256 * mm * dil) * 768 + hd * 64; J.os = (long)dil * 768;
                        J.lse = LSE + (brow + (size_t)256 * mm * dil) * 12 + hd; J.ls = (long)dil * 12; J.kbias = nullptr;
                        J.kt_lo = mm == 0 ? 0 : 4 * mm - 2; J.kt_hi = 4 * mm + 4; J.mode = 2; J.q_off = 256 * mm; }
                    else J = mem_job(u - 1536, HP, 2560, 2304, mkv, Y, 512, 256);
                    attn_unit(J, lds, tid, wid, lane);
                }
            } else {
                for (int p = bx; p < 768 * 2 + 512; p += G) {
                    AttnJob J;
                    if (p < 1536) { const int pr = p % 768, k = p / 768, bh = pr >> 3, s = pr & 7, b = bh / 12, hh = bh % 12, qb = k == 0 ? s : 15 - s;
                        J.Q = HP + ((size_t)b * SEQ + 256 * qb) * 2560 + hh * 64; J.qs = 2560; J.K = HP + (size_t)b * SEQ * 2560 + 768 + hh * 64; J.ks = 2560; J.V = J.K + 768; J.vs = 2560;
                        J.O = Y + ((size_t)b * SEQ + 256 * qb) * 1024 + hh * 64; J.os = 1024; J.lse = nullptr; J.ls = 0; J.kbias = NEGC + (size_t)bh * SEQ;
                        J.kt_lo = 0; J.kt_hi = 4 * qb + 4; J.mode = 1; J.q_off = 256 * qb; }
                    else J = mem_job(p - 1536, HP, 2560, 2304, mkv, Y, 1024, 768);
                    attn_unit(J, lds, tid, wid, lane);
                }
            }
        } else if (slot == 6) {
            for (int i = bx * 512 + tid; i < M * 32; i += G * 512) { const int row = i >> 5, hg = (i >> 3) & 3, ch = i & 7;
                const float l0 = LSE[(size_t)row * 12 + hg], l1 = LSE[(size_t)row * 12 + 4 + hg], l2 = LSE[(size_t)row * 12 + 8 + hg];
                const float mx = fmaxf(l0, fmaxf(l1, l2)); float w0 = expf(l0 - mx), w1 = expf(l1 - mx), w2 = expf(l2 - mx); const float inv = 1.0f / (w0 + w1 + w2); w0 *= inv; w1 *= inv; w2 *= inv;
                const u32x4 a0 = *(const u32x4*)(OB + (size_t)row * 768 + hg * 64 + 8 * ch), a1 = *(const u32x4*)(OB + (size_t)row * 768 + (4 + hg) * 64 + 8 * ch), a2 = *(const u32x4*)(OB + (size_t)row * 768 + (8 + hg) * 64 + 8 * ch);
                u32x4 o;
                o.x = pk2(w0 * bflo(a0.x) + w1 * bflo(a1.x) + w2 * bflo(a2.x), w0 * bfhi(a0.x) + w1 * bfhi(a1.x) + w2 * bfhi(a2.x));
                o.y = pk2(w0 * bflo(a0.y) + w1 * bflo(a1.y) + w2 * bflo(a2.y), w0 * bfhi(a0.y) + w1 * bfhi(a1.y) + w2 * bfhi(a2.y));
                o.z = pk2(w0 * bflo(a0.z) + w1 * bflo(a1.z) + w2 * bflo(a2.z), w0 * bfhi(a0.z) + w1 * bfhi(a1.z) + w2 * bfhi(a2.z));
                o.w = pk2(w0 * bflo(a0.w) + w1 * bflo(a1.w) + w2 * bflo(a2.w), w0 * bfhi(a0.w) + w1 * bfhi(a1.w) + w2 * bfhi(a2.w));
                *(u32x4*)(Y + (size_t)row * 512 + hg * 64 + 8 * ch) = o; }
        }
        if (ph + 1 < ph_end) grid.sync();
    }
}

extern "C" void kernel_launch(void* const* d_in, const int* in_sizes, int n_in, void* d_out, int out_size, void* d_ws, size_t ws_size, hipStream_t stream) {
    static int grid = 0;
    if (grid == 0) {
        if (n_in != 18 || out_size != M * D || ws_size < WS_END) { fprintf(stderr, "kernel_launch: unexpected problem: n_in %d out %d ws %zu (need %zu)\n", n_in, out_size, ws_size, (size_t)WS_END); grid = -1; return; }
        int dev = 0, cus = 0, per_cu = 0;
        hipGetDevice(&dev); hipDeviceGetAttribute(&cus, hipDeviceAttributeMultiprocessorCount, dev);
        if (hipFuncSetAttribute((const void*)mega_fwd, hipFuncAttributeMaxDynamicSharedMemorySize, LDS_BYTES) != hipSuccess) { fprintf(stderr, "kernel_launch: hipFuncSetAttribute failed\n"); grid = -1; return; }
        if (hipOccupancyMaxActiveBlocksPerMultiprocessor(&per_cu, (const void*)mega_fwd, 512, LDS_BYTES) != hipSuccess || per_cu < 1) { fprintf(stderr, "kernel_launch: occupancy query says %d\n", per_cu); per_cu = 1; }
        (void)hipGetLastError();
        grid = cus * 1;
    }
    if (grid < 0) return;
    Args a{};
    for (int i = 0; i < 18; ++i) a.in[i] = d_in[i];
    a.out = (float*)d_out; a.ws = (unsigned char*)d_ws; a.ph_lo = 0; a.ph_hi = 1 + 12 * DEPTH;
    void* args[] = {&a};
    hipError_t e = hipLaunchCooperativeKernel((const void*)mega_fwd, dim3(grid), dim3(512), args, LDS_BYTES, stream);
    if (e != hipSuccess) fprintf(stderr, "cooperative launch failed: %s (grid %d)\n", hipGetErrorString(e), grid);
}
```

```cpp
#include <hip/hip_runtime.h>
#include <hip/hip_cooperative_groups.h>
#include <cstdio>
#include <cstdint>
namespace cg = cooperative_groups;
#define DI __device__ __forceinline__
DI unsigned pk2(float lo, float hi) { typedef float f2_t __attribute__((ext_vector_type(2))); typedef __bf16 b2_t __attribute__((ext_vector_type(2))); f2_t v = {lo, hi}; b2_t b = __builtin_convertvector(v, b2_t); return __builtin_bit_cast(unsigned, b); }
DI float bflo(unsigned w) { return __uint_as_float(w << 16); }
DI float bfhi(unsigned w) { return __uint_as_float(w & 0xffff0000u); }
namespace pg8 {
#define PG8_LAS __attribute__((address_space(3)))
typedef unsigned short bf16_t;
typedef short bf16x8 __attribute__((ext_vector_type(8)));
typedef float f32x4 __attribute__((ext_vector_type(4)));
typedef unsigned u32x4 __attribute__((ext_vector_type(4)));
constexpr int BM = 256, BK = 64, HALF = 128, HTB = HALF * BK * 2  , STAGE_BYTES = 8 * HTB, NXCD = 8, WGM = 8;

__host__ __device__ __forceinline__ int lds_byte(int r, int c) { const int st = (r >> 4) * 2 + (c >> 5), rr = r & 15, cc = c & 31, ob = rr * 64 + cc * 2; return st * 1024 + (ob ^ (((ob >> 9) & 1) << 5)); }
__host__ __device__ __forceinline__ void stage_rc(int b, int& R, int& C) { const int st = b / 1024, sb = b % 1024, swz = sb ^ (((sb >> 9) & 1) << 5); R = (st >> 1) * 16 + swz / 64; C = (st & 1) * 32 + (swz % 64) / 2; }
__host__ __device__ __forceinline__ int perm32(int rho) { const int n = rho >> 4, i = rho & 15; return 8 * (i >> 2) + 4 * n + (i & 3); }

struct Unit { int pm, pn; };
struct Gemm { const bf16_t* A; const bf16_t* Bt; int M, N, K; };

struct StaticOrder {
    int nM, nN, nwg, G, c;
    __host__ __device__ void init(int M, int N, int G_, int c_) { nM = M / BM; nN = N / BM; nwg = nM * nN; G = G_; c = c_; }
    __host__ __device__ bool next(int i, Unit& u) const {
        const long L = (long)i * G + c; if (L >= nwg) return false;
        int wgid = (int)L; { const int q = nwg / NXCD, r = nwg % NXCD, xcd = wgid % NXCD, off = wgid / NXCD; wgid = (xcd < r ? xcd * (q + 1) : r * (q + 1) + (xcd - r) * q) + off; }
        const int nig = WGM * nN, gid = wgid / nig, fm = gid * WGM, gsz = (nM - fm) < WGM ? (nM - fm) : WGM;
        u.pm = fm + ((wgid % nig) % gsz); u.pn = (wgid % nig) / gsz; return true;
    }
    __device__ __forceinline__ void a_ready(const Unit&) const {}
    __device__ __forceinline__ void done(const Unit&) const {}
};

typedef unsigned u32x4e __attribute__((ext_vector_type(4)));
DI u32x4e pack8(const f32x4& a, const f32x4& b) { u32x4e w; w.x = pk2(a[0], a[1]); w.y = pk2(a[2], a[3]); w.z = pk2(b[0], b[1]); w.w = pk2(b[2], b[3]); return w; }
DI float silu_mul(float g, float u) { return g * u * __builtin_amdgcn_rcpf(1.0f + __builtin_amdgcn_exp2f(-1.4426950408889634f * g)); }
DI float gelu_tanh(float x) { const float z2 = 1.5957691216057308f * (x + 0.044715f * x * x * x); return x * __builtin_amdgcn_rcpf(1.0f + __builtin_amdgcn_exp2f(-1.4426950408889634f * z2)); }
struct EpiPlain { static constexpr bool PERM = true, AFTER_DRAIN = false; bf16_t* O; int ldc; int wrap;
    __device__ __forceinline__ void operator()(const f32x4 (&acc)[2][2][4][2], const Unit& u, int wr, int wc, int fr, int fq) const {
        const int row0 = u.pm * BM + wr * 64 + fr, col0 = (u.pn % wrap) * BM + wc * 32 + 8 * fq;
#pragma unroll
        for (int ai = 0; ai < 2; ++ai)
#pragma unroll
            for (int m = 0; m < 4; ++m) { bf16_t* rowp = O + (size_t)(row0 + ai * HALF + m * 16) * ldc + col0;
#pragma unroll
                for (int bj = 0; bj < 2; ++bj) *(u32x4e*)(rowp + bj * HALF) = pack8(acc[ai][bj][m][0], acc[ai][bj][m][1]); }
    }
};
struct EpiSwiglu { static constexpr bool PERM = true, AFTER_DRAIN = false; bf16_t* H; int ldc;
    __device__ __forceinline__ void operator()(const f32x4 (&acc)[2][2][4][2], const Unit& u, int wr, int wc, int fr, int fq) const {
        const int row0 = u.pm * BM + wr * 64 + fr, col0 = u.pn * HALF + wc * 32 + 8 * fq;
#pragma unroll
        for (int ai = 0; ai < 2; ++ai)
#pragma unroll
            for (int m = 0; m < 4; ++m) { f32x4 h0, h1;
#pragma unroll
                for (int j = 0; j < 4; ++j) { h0[j] = silu_mul(acc[ai][0][m][0][j], acc[ai][1][m][0][j]); h1[j] = silu_mul(acc[ai][0][m][1][j], acc[ai][1][m][1][j]); }
                *(u32x4e*)(H + (size_t)(row0 + ai * HALF + m * 16) * ldc + col0) = pack8(h0, h1); }
    }
};
struct EpiYss { static constexpr bool PERM = true, AFTER_DRAIN = false; bf16_t* Y; float* ssp;
    __device__ __forceinline__ void operator()(const f32x4 (&acc)[2][2][4][2], const Unit& u, int wr, int wc, int fr, int fq) const {
        const int row0 = u.pm * BM + wr * 64 + fr, col0 = u.pn * BM + wc * 32 + 8 * fq;
#pragma unroll
        for (int ai = 0; ai < 2; ++ai)
#pragma unroll
            for (int m = 0; m < 4; ++m) { const int row = row0 + ai * HALF + m * 16; float s = 0.f;
#pragma unroll
                for (int bj = 0; bj < 2; ++bj) { const f32x4 v0 = acc[ai][bj][m][0], v1 = acc[ai][bj][m][1];
                    s += (v0[0] * v0[0] + v0[1] * v0[1]) + (v0[2] * v0[2] + v0[3] * v0[3]) + (v1[0] * v1[0] + v1[1] * v1[1]) + (v1[2] * v1[2] + v1[3] * v1[3]);
                    *(u32x4e*)(Y + (size_t)row * 1024 + col0 + bj * HALF) = pack8(v0, v1); }
                s += __shfl_xor(s, 16); s += __shfl_xor(s, 32);
                if (fq == 0) ssp[(size_t)row * 16 + u.pn * 4 + wc] = s; }
    }
};
struct EpiInA { static constexpr bool PERM = true, AFTER_DRAIN = false; bf16_t* O; float* vst;
    __device__ __forceinline__ void operator()(const f32x4 (&acc)[2][2][4][2], const Unit& u, int wr, int wc, int fr, int fq) const {
        const int row0 = u.pm * BM + wr * 64 + fr, col0 = u.pn * BM + wc * 32 + 8 * fq; const bool act = u.pn < 6, st = u.pn >= 3 && u.pn < 6;
#pragma unroll
        for (int ai = 0; ai < 2; ++ai)
#pragma unroll
            for (int m = 0; m < 4; ++m) { const int row = row0 + ai * HALF + m * 16; float s1 = 0.f, s2 = 0.f;
#pragma unroll
                for (int bj = 0; bj < 2; ++bj) { f32x4 v0 = acc[ai][bj][m][0], v1 = acc[ai][bj][m][1];
                    if (act) {
#pragma unroll
                        for (int j = 0; j < 4; ++j) { v0[j] = gelu_tanh(v0[j]); v1[j] = gelu_tanh(v1[j]); } }
                    s1 += (v0[0] + v0[1]) + (v0[2] + v0[3]) + (v1[0] + v1[1]) + (v1[2] + v1[3]);
                    s2 += (v0[0] * v0[0] + v0[1] * v0[1]) + (v0[2] * v0[2] + v0[3] * v0[3]) + (v1[0] * v1[0] + v1[1] * v1[1]) + (v1[2] * v1[2] + v1[3] * v1[3]);
                    *(u32x4e*)(O + (size_t)row * 1792 + col0 + bj * HALF) = pack8(v0, v1); }
                if (st) { s1 += __shfl_xor(s1, 16); s1 += __shfl_xor(s1, 32); s2 += __shfl_xor(s2, 16); s2 += __shfl_xor(s2, 32);
                    if (fq == 0) { float* p = vst + ((size_t)row * 12 + (u.pn - 3) * 4 + wc) * 2; p[0] = s1; p[1] = s2; } } }
    }
};
struct EpiInB { static constexpr bool PERM = true, AFTER_DRAIN = false; bf16_t* O; const float* rc; const float* rs;
    __device__ __forceinline__ void operator()(const f32x4 (&acc)[2][2][4][2], const Unit& u, int wr, int wc, int fr, int fq) const {
        const int row0 = u.pm * BM + wr * 64 + fr;
        if (u.pn < 6) {
#pragma unroll
            for (int ai = 0; ai < 2; ++ai)
#pragma unroll
                for (int m = 0; m < 4; ++m) { const int row = row0 + ai * HALF + m * 16;
                    const f32x4 c0 = *(const f32x4*)(rc + (size_t)row * 32 + 8 * fq), c1 = *(const f32x4*)(rc + (size_t)row * 32 + 8 * fq + 4);
                    const f32x4 s0 = *(const f32x4*)(rs + (size_t)row * 32 + 8 * fq), s1 = *(const f32x4*)(rs + (size_t)row * 32 + 8 * fq + 4);
                    const f32x4 a0 = acc[ai][0][m][0], a1 = acc[ai][0][m][1], b0 = acc[ai][1][m][0], b1 = acc[ai][1][m][1];
                    const f32x4 o10 = a0 * c0 - b0 * s0, o11 = a1 * c1 - b1 * s1, o20 = b0 * c0 + a0 * s0, o21 = b1 * c1 + a1 * s1;
                    bf16_t* p = O + (size_t)row * 2560 + u.pn * BM + wc * 64 + 8 * fq;
                    *(u32x4e*)p = pack8(o10, o11); *(u32x4e*)(p + 32) = pack8(o20, o21); }
        } else {
            const int col0 = u.pn * BM + wc * 32 + 8 * fq;
#pragma unroll
            for (int ai = 0; ai < 2; ++ai)
#pragma unroll
                for (int m = 0; m < 4; ++m) { bf16_t* rowp = O + (size_t)(row0 + ai * HALF + m * 16) * 2560 + col0;
#pragma unroll
                    for (int bj = 0; bj < 2; ++bj) *(u32x4e*)(rowp + bj * HALF) = pack8(acc[ai][bj][m][0], acc[ai][bj][m][1]); }
        }
    }
};
struct EpiInC { static constexpr bool PERM = true, AFTER_DRAIN = false; bf16_t* O; float* logf_out; const float* fbias;
    __device__ __forceinline__ void operator()(const f32x4 (&acc)[2][2][4][2], const Unit& u, int wr, int wc, int fr, int fq) const {
        const int row0 = u.pm * BM + wr * 64 + fr;
        if (u.pn < 10) {
            const int col0 = u.pn * BM + wc * 32 + 8 * fq;
#pragma unroll
            for (int ai = 0; ai < 2; ++ai)
#pragma unroll
                for (int m = 0; m < 4; ++m) { bf16_t* rowp = O + (size_t)(row0 + ai * HALF + m * 16) * 2560 + col0;
#pragma unroll
                    for (int bj = 0; bj < 2; ++bj) *(u32x4e*)(rowp + bj * HALF) = pack8(acc[ai][bj][m][0], acc[ai][bj][m][1]); }
        } else if (wc == 0 && fq < 2) {
#pragma unroll
            for (int ai = 0; ai < 2; ++ai)
#pragma unroll
                for (int m = 0; m < 4; ++m) { const int row = row0 + ai * HALF + m * 16;
#pragma unroll
                    for (int n = 0; n < 2; ++n) { if (fq == 1 && n == 1) continue;
#pragma unroll
                        for (int j = 0; j < 4; ++j) { const int c = 8 * fq + 4 * n + j; const float z = acc[ai][0][m][n][j] + fbias[c];
                            logf_out[(size_t)row * 12 + c] = fminf(z, 0.f) - log1pf(expf(-fabsf(z))); } } }
        }
    }
};
struct MemKvOrder { int G, c;
    __device__ bool next(int i, Unit& u) const { const int L = i * G + c; if (L >= 64) return false; const int l = L >> 4, rem = L & 15; u.pm = l * 8 + (rem >> 1); u.pn = l * 2 + (rem & 1); return true; }
    __device__ __forceinline__ void a_ready(const Unit&) const {}
    __device__ __forceinline__ void done(const Unit&) const {}
};
template <class Epi, class Sched, bool ALIGN_EPI = false, bool SP2 = false>
__device__ __forceinline__ void gemm_phase(PG8_LAS unsigned char* lds, const Gemm g, const Sched& S, const Epi& E, const int tid) {
    const int wid = __builtin_amdgcn_readfirstlane(tid >> 6), lane = tid & 63, wr = wid >> 2, wc = wid & 3, fr = lane & 15, fq = lane >> 4;
    const int K = g.K, nt = K / BK;
    unsigned voffA[2], voffB[2];
#pragma unroll
    for (int i = 0; i < 2; ++i) { int R, C; stage_rc(tid * 16 + i * 8192, R, C); const int Rb = Epi::PERM ? ((R & ~31) + perm32(R & 31)) : R;
        voffA[i] = (unsigned)(R * K + C) * 2u; voffB[i] = (unsigned)(Rb * K + C) * 2u; }
    const size_t kstep = (size_t)(BK * 2);
    const size_t hstep = (size_t)HALF * K * 2;
    const size_t tstep = 2 * hstep;
    const unsigned ldsw = (unsigned)wid * 1024u;
    const int aoff = lds_byte(wr * 64 + fr, fq * 8), boff = lds_byte(wc * 32 + fr, fq * 8);
#define PG8_SA(b, h) (((b) * 2 + (h)) * HTB)
#define PG8_SB(b, h) ((4 + (b) * 2 + (h)) * HTB)
#define PG8_STAGE(bufoff, gbase, voff) do { _Pragma("unroll") for (int _i = 0; _i < 2; ++_i) \
        __builtin_amdgcn_global_load_lds((const unsigned*)((const char*)(gbase) + (voff)[_i]), (PG8_LAS unsigned*)(lds + (bufoff) + ldsw + _i * 8192), 16, 0, 0); } while (0)
#define PG8_LDA(dst, b, h) do { _Pragma("unroll") for (int m = 0; m < 4; ++m) _Pragma("unroll") for (int k = 0; k < 2; ++k) dst[m][k] = *(const PG8_LAS bf16x8*)(lds + PG8_SA(b, h) + aoff + m * 2048 + k * 1024); } while (0)
#define PG8_LDB(dst, b, h) do { _Pragma("unroll") for (int n = 0; n < 2; ++n) _Pragma("unroll") for (int k = 0; k < 2; ++k) dst[n][k] = *(const PG8_LAS bf16x8*)(lds + PG8_SB(b, h) + boff + n * 2048 + k * 1024); } while (0)
#define PG8_MMA(ai, bj, At, Bt) do { __builtin_amdgcn_s_setprio(1); _Pragma("unroll") for (int m = 0; m < 4; ++m) _Pragma("unroll") for (int n = 0; n < 2; ++n) _Pragma("unroll") for (int k = 0; k < 2; ++k) \
        acc[ai][bj][m][n] = __builtin_amdgcn_mfma_f32_16x16x32_bf16(Bt[n][k], At[m][k], acc[ai][bj][m][n], 0, 0, 0); __builtin_amdgcn_s_setprio(0); } while (0)
#define PG8_WAIT_V(n) asm volatile("s_waitcnt vmcnt(" #n ")" ::: "memory")
#define PG8_WAIT_L(n) asm volatile("s_waitcnt lgkmcnt(" #n ")" ::: "memory")
#define PG8_BAR __builtin_amdgcn_s_barrier()
#define PG8_SCHED __builtin_amdgcn_sched_barrier(0)
    Unit cur, nxt; int ui = 0;
    if (!S.next(0, cur)) return;
    f32x4 acc[2][2][4][2];
#pragma unroll
    for (int a = 0; a < 2; ++a)
#pragma unroll
        for (int b = 0; b < 2; ++b)
#pragma unroll
            for (int m = 0; m < 4; ++m)
#pragma unroll
                for (int n = 0; n < 2; ++n) acc[a][b][m][n] = (f32x4){0.f, 0.f, 0.f, 0.f};
    bf16x8 At[4][2], B0[2][2], B1[2][2];
    const char* cA = (const char*)g.A + (size_t)cur.pm * tstep; const char* cB = (const char*)g.Bt + (size_t)cur.pn * tstep;
    S.a_ready(cur);
    if constexpr (SP2) {
        PG8_STAGE(PG8_SB(0, 0), cB, voffB); PG8_STAGE(PG8_SB(0, 1), cB + hstep, voffB); PG8_STAGE(PG8_SA(0, 0), cA, voffA); PG8_STAGE(PG8_SA(0, 1), cA + hstep, voffA);
        if (wr == 1) PG8_BAR;
        PG8_WAIT_V(2); PG8_BAR;
        PG8_STAGE(PG8_SB(1, 0), cB + kstep, voffB); PG8_STAGE(PG8_SA(1, 0), cA + kstep, voffA); PG8_STAGE(PG8_SB(1, 1), cB + hstep + kstep, voffB);
        PG8_WAIT_V(6); PG8_BAR;
    } else {
        PG8_STAGE(PG8_SB(0, 0), cB, voffB); PG8_STAGE(PG8_SA(0, 0), cA, voffA); PG8_STAGE(PG8_SB(0, 1), cB + hstep, voffB); PG8_STAGE(PG8_SA(0, 1), cA + hstep, voffA);
        if (wr == 1) PG8_BAR;
        PG8_WAIT_V(4); PG8_BAR;
        PG8_STAGE(PG8_SB(1, 0), cB + kstep, voffB); PG8_STAGE(PG8_SA(1, 0), cA + kstep, voffA); PG8_STAGE(PG8_SB(1, 1), cB + hstep + kstep, voffB);
        PG8_WAIT_V(6); PG8_BAR;
    }
    for (;;) {
        const bool has_next = S.next(ui + 1, nxt);
        const char* nA = has_next ? (const char*)g.A + (size_t)nxt.pm * tstep : cA; const char* nB = has_next ? (const char*)g.Bt + (size_t)nxt.pn * tstep : cB;
        for (int t = 0; t < nt; t += 2) {
            const bool last = (t == nt - 2);
            const char* a1 = cA + (size_t)(t + 1) * kstep;
            const char* a2 = last ? nA : cA + (size_t)(t + 2) * kstep; const char* b2 = last ? nB : cB + (size_t)(t + 2) * kstep;
            const char* a3 = a2 + kstep; const char* b3 = b2 + kstep;
            if (last && has_next) S.a_ready(nxt);
            if constexpr (SP2) {
            PG8_LDB(B0, 0, 0); PG8_LDB(B1, 0, 1); PG8_SCHED; PG8_LDA(At, 0, 0); PG8_STAGE(PG8_SA(1, 1), a1 + hstep, voffA);
            PG8_WAIT_V(8); PG8_WAIT_L(0); PG8_BAR; PG8_MMA(0, 0, At, B0); PG8_MMA(0, 1, At, B1); PG8_BAR; PG8_SCHED;
            PG8_LDA(At, 0, 1); PG8_STAGE(PG8_SB(0, 0), b2, voffB); PG8_STAGE(PG8_SB(0, 1), b2 + hstep, voffB); PG8_STAGE(PG8_SA(0, 0), a2, voffA);
            PG8_WAIT_V(8); PG8_WAIT_L(0); PG8_BAR; PG8_MMA(1, 0, At, B0); PG8_MMA(1, 1, At, B1); PG8_BAR; PG8_SCHED;
            PG8_LDB(B0, 1, 0); PG8_LDB(B1, 1, 1); PG8_SCHED; PG8_LDA(At, 1, 0); PG8_STAGE(PG8_SA(0, 1), a2 + hstep, voffA);
            PG8_WAIT_V(8); PG8_WAIT_L(0); PG8_BAR; PG8_MMA(0, 0, At, B0); PG8_MMA(0, 1, At, B1); PG8_BAR; PG8_SCHED;
            PG8_LDA(At, 1, 1); PG8_STAGE(PG8_SB(1, 0), b3, voffB); PG8_STAGE(PG8_SB(1, 1), b3 + hstep, voffB); PG8_STAGE(PG8_SA(1, 0), a3, voffA);
            PG8_WAIT_V(8); PG8_WAIT_L(0); PG8_BAR; PG8_MMA(1, 0, At, B0); PG8_MMA(1, 1, At, B1); PG8_BAR; PG8_SCHED;
            } else {
            PG8_LDB(B0, 0, 0); PG8_SCHED; PG8_LDA(At, 0, 0); PG8_STAGE(PG8_SA(1, 1), a1 + hstep, voffA);
            PG8_WAIT_L(8); PG8_BAR; PG8_WAIT_L(0); PG8_MMA(0, 0, At, B0); PG8_BAR; PG8_SCHED;
            PG8_LDB(B1, 0, 1); PG8_STAGE(PG8_SB(0, 0), b2, voffB);
            PG8_BAR; PG8_WAIT_L(0); PG8_MMA(0, 1, At, B1); PG8_BAR;
            PG8_LDA(At, 0, 1); PG8_STAGE(PG8_SA(0, 0), a2, voffA);
            PG8_BAR; PG8_WAIT_L(0); PG8_MMA(1, 0, At, B0); PG8_BAR; PG8_SCHED;
            PG8_STAGE(PG8_SB(0, 1), b2 + hstep, voffB);
            PG8_WAIT_V(6); PG8_BAR; PG8_MMA(1, 1, At, B1); PG8_BAR;
            PG8_LDB(B0, 1, 0); PG8_SCHED; PG8_LDA(At, 1, 0); PG8_STAGE(PG8_SA(0, 1), a2 + hstep, voffA);
            PG8_WAIT_L(8); PG8_BAR; PG8_WAIT_L(0); PG8_MMA(0, 0, At, B0); PG8_BAR; PG8_SCHED;
            PG8_LDB(B1, 1, 1); PG8_STAGE(PG8_SB(1, 0), b3, voffB);
            PG8_BAR; PG8_WAIT_L(0); PG8_MMA(0, 1, At, B1); PG8_BAR;
            PG8_LDA(At, 1, 1); PG8_STAGE(PG8_SA(1, 0), a3, voffA);
            PG8_BAR; PG8_WAIT_L(0); PG8_MMA(1, 0, At, B0); PG8_BAR; PG8_SCHED;
            PG8_STAGE(PG8_SB(1, 1), b3 + hstep, voffB);
            PG8_WAIT_V(6); PG8_BAR; PG8_MMA(1, 1, At, B1); PG8_BAR;
            }
        }
        if constexpr (ALIGN_EPI) { if (wr == 0) PG8_BAR; }
        if constexpr (!Epi::AFTER_DRAIN) { E(acc, cur, wr, wc, fr, fq); S.done(cur); }
        if (!has_next) break;
#pragma unroll
        for (int a = 0; a < 2; ++a)
#pragma unroll
            for (int b = 0; b < 2; ++b)
#pragma unroll
                for (int m = 0; m < 4; ++m)
#pragma unroll
                    for (int n = 0; n < 2; ++n) acc[a][b][m][n] = (f32x4){0.f, 0.f, 0.f, 0.f};
        cur = nxt; cA = nA; cB = nB; ++ui;
        if constexpr (ALIGN_EPI) { if (wr == 1) PG8_BAR; }
    }
    PG8_WAIT_V(0);
    if constexpr (!ALIGN_EPI) { if (wr == 0) PG8_BAR; }
    PG8_BAR;
    if constexpr (Epi::AFTER_DRAIN) { E.fused(acc, cur, wr, wc, fr, fq, lds, wid, lane); S.done(cur); }
#undef PG8_SA
#undef PG8_SB
#undef PG8_STAGE
#undef PG8_LDA
#undef PG8_LDB
#undef PG8_MMA
#undef PG8_WAIT_V
#undef PG8_WAIT_L
#undef PG8_BAR
#undef PG8_SCHED
}
}
#define LAS __attribute__((address_space(3)))
typedef unsigned short bf16;
typedef float f32x4 __attribute__((ext_vector_type(4)));
typedef float f32x16 __attribute__((ext_vector_type(16)));
typedef unsigned u32x4 __attribute__((ext_vector_type(4)));
typedef unsigned u32x2 __attribute__((ext_vector_type(2)));
typedef short bf16x8 __attribute__((ext_vector_type(8)));
typedef short s16x4 __attribute__((ext_vector_type(4)));
constexpr int NB = 8, SEQ = 4096, D = 1024, M = NB * SEQ, FF = 2816, NGU = 2 * FF, NMEM = 256, DEPTH = 4;
constexpr float RMS_EPS = 1e-6f, LN_EPS = 1e-5f, LOG2E = 1.4426950408889634f, LN2 = 0.6931471805599453f;
constexpr float C2 = 0.125f * LOG2E;
constexpr size_t MiB = 1u << 20;
constexpr size_t WS_WGU = 1 * MiB;
constexpr size_t WS_WD = WS_WGU + 88 * MiB;
constexpr size_t WS_WINA = WS_WD + 44 * MiB;
constexpr size_t WS_WINB = WS_WINA + 7 * MiB;
constexpr size_t WS_WINC = WS_WINB + 5 * MiB;
constexpr size_t WS_WOUTA = WS_WINC + 6 * MiB;
constexpr size_t WS_WOUTB = WS_WOUTA + 4 * MiB;
constexpr size_t WS_WOUTC = WS_WOUTB + 1 * MiB;
constexpr size_t WS_WMKV = WS_WOUTC + 2 * MiB;
constexpr size_t WS_SW = WS_WMKV + 4 * MiB;
constexpr size_t WS_MEMN = WS_SW + 1 * MiB;
constexpr size_t WS_MKV = WS_MEMN + 16 * MiB;
constexpr size_t WS_RC = WS_MKV + 8 * MiB;
constexpr size_t WS_RS = WS_RC + 4 * MiB;
constexpr size_t WS_SSP = WS_RS + 4 * MiB;
constexpr size_t WS_VST = WS_SSP + 2 * MiB;
constexpr size_t WS_LOGF = WS_VST + 3 * MiB;
constexpr size_t WS_NEGC = WS_LOGF + 2 * MiB;
constexpr size_t WS_LSE = WS_NEGC + 2 * MiB;
constexpr size_t WS_XN = WS_LSE + 2 * MiB;
constexpr size_t WS_Y = WS_XN + 64 * MiB;
constexpr size_t WS_YO = WS_Y + 64 * MiB;
constexpr size_t WS_OB = WS_YO + 64 * MiB;
constexpr size_t WS_HP = WS_OB + 48 * MiB;
constexpr size_t WS_END = WS_HP + 176 * MiB;
constexpr int LDS_BYTES = 147456;
constexpr int MISC_OFF = 131072 + 320;
constexpr size_t WS_BAR = 65536, CTL_ZERO_BYTES = 1 * MiB;

struct Args { const void* in[18]; float* out; unsigned char* ws; int ph_lo, ph_hi; };

DI const void* launder_s(const void* p) { asm volatile("" : "+s"(p)); return p; }
DI float wave_sum(float v) {
#pragma unroll
    for (int o = 1; o < 64; o <<= 1) v += __shfl_xor(v, o);
    return v;
}
DI int src_col(int mode, int n) {
    if (mode == 1) { const int t = n >> 8, j = n & 255; return j < 128 ? 128 * t + j : FF + 128 * t + (j - 128); }
    if (mode == 2) { if (n >= 1536) return n; const int t = n >> 8, j = n & 255, half = j >> 7, p = j & 127, hd = p >> 5, d = p & 31; return 256 * t + hd * 64 + half * 32 + d; }
    if (mode == 3) { if (n < 2304) return n; if (n < 2560) return n + 12; if (n < 2572) return n - 2560 + 2304; return -1; }
    return n;
}
DI void transpose_item(const float* W, int K, int Nsrc, bf16* WT, int Nout, int mode, LAS float* scr, int item, int lane) {
    const int nblk = Nout / 32, kb = item / nblk, nb = item % nblk, k0 = 64 * kb, n0 = 32 * nb;
    const int sc = src_col(mode, n0 + (lane & 31));
#pragma unroll 8
    for (int i = 0; i < 32; ++i) { const int kk = 2 * i + (lane >> 5); scr[kk * 33 + (lane & 31)] = sc >= 0 ? W[(size_t)(k0 + kk) * Nsrc + sc] : 0.f; }
    asm volatile("s_waitcnt lgkmcnt(0)" ::: "memory");
    const int c = lane & 7;
#pragma unroll
    for (int j = 0; j < 4; ++j) { const int n = (lane >> 3) + 8 * j; const LAS float* s = scr + (8 * c) * 33 + n;
        u32x4 o; o.x = pk2(s[0 * 33], s[1 * 33]); o.y = pk2(s[2 * 33], s[3 * 33]); o.z = pk2(s[4 * 33], s[5 * 33]); o.w = pk2(s[6 * 33], s[7 * 33]);
        *(u32x4*)(WT + (size_t)(n0 + n) * K + k0 + 8 * c) = o; }
    asm volatile("s_waitcnt lgkmcnt(0)" ::: "memory");
}
DI void rms_store(const f32x4 (&v)[4], const float* g, bf16* orow, int lane) {
    float s2 = 0.f;
#pragma unroll
    for (int j = 0; j < 4; ++j) s2 += (v[j][0] * v[j][0] + v[j][1] * v[j][1]) + (v[j][2] * v[j][2] + v[j][3] * v[j][3]);
    const float rs = 1.0f / sqrtf(wave_sum(s2) * (1.0f / D) + RMS_EPS);
#pragma unroll
    for (int j = 0; j < 4; ++j) { const f32x4 gg = *(const f32x4*)(g + 4 * lane + 256 * j); const f32x4 o = v[j] * rs * gg;
        u32x2 w; w.x = pk2(o[0], o[1]); w.y = pk2(o[2], o[3]); *(u32x2*)(orow + 4 * lane + 256 * j) = w; }
}
DI void norm_pass(const float* xin, const bf16* yo, const float* ssp, const float* gpost, float scale, float* xout, const float* gnext, bf16* xn, int gw, int ngw, int lane) {
    for (int row = gw; row < M; row += ngw) {
        f32x4 v[4];
#pragma unroll
        for (int j = 0; j < 4; ++j) v[j] = *(const f32x4*)(xin + (size_t)row * D + 4 * lane + 256 * j);
        const float part = lane < 16 ? ssp[(size_t)row * 16 + lane] : 0.f;
        const float r = scale / sqrtf(wave_sum(part) * (1.0f / D) + RMS_EPS);
#pragma unroll
        for (int j = 0; j < 4; ++j) { const u32x2 y = *(const u32x2*)(yo + (size_t)row * D + 4 * lane + 256 * j); const f32x4 gg = *(const f32x4*)(gpost + 4 * lane + 256 * j);
            f32x4 yy; yy[0] = bflo(y.x); yy[1] = bfhi(y.x); yy[2] = bflo(y.y); yy[3] = bfhi(y.y);
            v[j] = v[j] + yy * r * gg; *(f32x4*)(xout + (size_t)row * D + 4 * lane + 256 * j) = v[j]; }
        if (gnext) rms_store(v, gnext, xn + (size_t)row * D, lane);
    }
}
#define MFMA32(a, b, c) __builtin_amdgcn_mfma_f32_32x32x16_bf16((a), (b), (c), 0, 0, 0)
constexpr int TROW = 144;
constexpr int TB = 64 * TROW;
DI s16x4 trd(const LAS unsigned char* p) { return __builtin_bit_cast(s16x4, __builtin_amdgcn_ds_read_tr16_b64_v4i16((LAS s16x4*)p)); }
DI bf16x8 vfrag(const LAS unsigned char* p) { const s16x4 lo = trd(p), hi = trd(p + 8 * TROW); return __builtin_shufflevector(lo, hi, 0, 1, 2, 3, 4, 5, 6, 7); }
template <int S> DI bf16x8 packp(const f32x16& x) { u32x4 w; w.x = pk2(x[8 * S], x[8 * S + 1]); w.y = pk2(x[8 * S + 2], x[8 * S + 3]); w.z = pk2(x[8 * S + 4], x[8 * S + 5]); w.w = pk2(x[8 * S + 6], x[8 * S + 7]); return __builtin_bit_cast(bf16x8, w); }
struct AttnJob { const bf16* Q; const bf16* K; const bf16* V; bf16* O; float* lse; const float* kbias; long qs, ks, vs, os, ls; int kt_lo, kt_hi, mode, q_off; };
DI void attn_unit(const AttnJob& J, LAS unsigned char* lds, int tid, int wid, int lane) {
    const int r = lane & 31, h = lane >> 5;
    bf16x8 qr[4];
    { const bf16* qp = J.Q + (long)(32 * wid + r) * J.qs + 8 * h;
#pragma unroll
      for (int ds = 0; ds < 4; ++ds) qr[ds] = *(const bf16x8*)(qp + 16 * ds); }
    float m = -1e30f, l = 0.f; f32x16 o0, o1;
#pragma unroll
    for (int i = 0; i < 16; ++i) { o0[i] = 0.f; o1[i] = 0.f; }
    const int qa0 = J.q_off + 32 * wid, qa = qa0 + r;
    const int srow = tid >> 3, sch = tid & 7;
    const bf16* kp = J.K + (long)srow * J.ks + 8 * sch; const bf16* vp = J.V + (long)srow * J.vs + 8 * sch;
    const int voff = (4 * h + ((lane & 15) >> 2)) * TROW + ((lane >> 4) & 1) * 32 + (lane & 3) * 8;
    u32x4 kreg = *(const u32x4*)(kp + (long)J.kt_lo * 64 * J.ks), vreg = *(const u32x4*)(vp + (long)J.kt_lo * 64 * J.vs);
    int cur = 0;
    for (int kt = J.kt_lo; kt < J.kt_hi; ++kt) {
        LAS unsigned char* kb = lds + cur * TB; LAS unsigned char* vb = lds + 2 * TB + cur * TB;
        *(LAS u32x4*)(kb + srow * TROW + sch * 16) = kreg; *(LAS u32x4*)(vb + srow * TROW + sch * 16) = vreg;
        __syncthreads();
        if (kt + 1 < J.kt_hi) { kreg = *(const u32x4*)(kp + (long)(kt + 1) * 64 * J.ks); vreg = *(const u32x4*)(vp + (long)(kt + 1) * 64 * J.vs); }
        const int k0 = 64 * kt;
        bool skip = false, need_mask = false;
        if (J.mode == 1) { skip = k0 > qa0 + 31; need_mask = k0 + 63 > qa0; }
        else if (J.mode == 2) { skip = (k0 > qa0 + 31) || (k0 + 63 < qa0 - 128); need_mask = !((k0 + 63 <= qa0) && (qa0 + 31 - k0 <= 128)); }
        if (!skip) {
            f32x16 p0, p1;
#pragma unroll
            for (int i = 0; i < 16; ++i) { p0[i] = 0.f; p1[i] = 0.f; }
#pragma unroll
            for (int ds = 0; ds < 4; ++ds) { const bf16x8 a0 = *(const LAS bf16x8*)(kb + r * TROW + 32 * ds + 16 * h), a1 = *(const LAS bf16x8*)(kb + (32 + r) * TROW + 32 * ds + 16 * h);
                p0 = MFMA32(a0, qr[ds], p0); p1 = MFMA32(a1, qr[ds], p1); }
#pragma unroll
            for (int g = 0; g < 4; ++g) { f32x4 b0 = {0.f, 0.f, 0.f, 0.f}, b1 = {0.f, 0.f, 0.f, 0.f};
                if (J.kbias) { b0 = *(const f32x4*)(J.kbias + k0 + 8 * g + 4 * h); b1 = *(const f32x4*)(J.kbias + k0 + 32 + 8 * g + 4 * h); }
#pragma unroll
                for (int j = 0; j < 4; ++j) { p0[4 * g + j] = __builtin_fmaf(p0[4 * g + j], C2, b0[j]); p1[4 * g + j] = __builtin_fmaf(p1[4 * g + j], C2, b1[j]); } }
            if (need_mask) {
#pragma unroll
                for (int i = 0; i < 16; ++i) { const int ka = k0 + (i & 3) + 8 * (i >> 2) + 4 * h, kb2 = ka + 32;
                    const bool bad0 = J.mode == 1 ? (ka > qa) : (ka > qa || qa - ka > 128), bad1 = J.mode == 1 ? (kb2 > qa) : (kb2 > qa || qa - kb2 > 128);
                    if (bad0) p0[i] = -INFINITY; if (bad1) p1[i] = -INFINITY; } }
            float mx = fmaxf(p0[0], p1[0]);
#pragma unroll
            for (int i = 1; i < 16; ++i) mx = fmaxf(mx, fmaxf(p0[i], p1[i]));
            mx = fmaxf(mx, __shfl_xor(mx, 32));
            const float mn = fmaxf(m, mx), alpha = __builtin_amdgcn_exp2f(m - mn); m = mn;
            float ps = 0.f;
#pragma unroll
            for (int i = 0; i < 16; ++i) { p0[i] = __builtin_amdgcn_exp2f(p0[i] - mn); p1[i] = __builtin_amdgcn_exp2f(p1[i] - mn); ps += p0[i] + p1[i]; }
            l = l * alpha + ps;
#pragma unroll
            for (int i = 0; i < 16; ++i) { o0[i] *= alpha; o1[i] *= alpha; }
            const LAS unsigned char* vl = vb + voff;
            { const bf16x8 b = packp<0>(p0); o0 = MFMA32(vfrag(vl), b, o0); o1 = MFMA32(vfrag(vl + 64), b, o1); }
            { const bf16x8 b = packp<1>(p0); o0 = MFMA32(vfrag(vl + 16 * TROW), b, o0); o1 = MFMA32(vfrag(vl + 16 * TROW + 64), b, o1); }
            { const bf16x8 b = packp<0>(p1); o0 = MFMA32(vfrag(vl + 32 * TROW), b, o0); o1 = MFMA32(vfrag(vl + 32 * TROW + 64), b, o1); }
            { const bf16x8 b = packp<1>(p1); o0 = MFMA32(vfrag(vl + 48 * TROW), b, o0); o1 = MFMA32(vfrag(vl + 48 * TROW + 64), b, o1); }
        }
        cur ^= 1;
    }
    l += __shfl_xor(l, 32);
    const float inv = 1.0f / l;
    bf16* op = J.O + (long)(32 * wid + r) * J.os + 4 * h;
#pragma unroll
    for (int g = 0; g < 4; ++g) { u32x2 w0, w1; w0.x = pk2(o0[4 * g] * inv, o0[4 * g + 1] * inv); w0.y = pk2(o0[4 * g + 2] * inv, o0[4 * g + 3] * inv);
        w1.x = pk2(o1[4 * g] * inv, o1[4 * g + 1] * inv); w1.y = pk2(o1[4 * g + 2] * inv, o1[4 * g + 3] * inv);
        *(u32x2*)(op + 8 * g) = w0; *(u32x2*)(op + 32 + 8 * g) = w1; }
    if (J.lse && h == 0) J.lse[(long)(32 * wid + r) * J.ls] = (m + __builtin_amdgcn_logf(l)) * LN2;
    __syncthreads();
}
DI AttnJob mem_job(int u, const bf16* P, int ldp, int qmoff, const bf16* mkv, bf16* Y, int ldy, int yoff) {
    const int b = u >> 6, mh = (u >> 4) & 3, qb = u & 15; AttnJob J;
    J.Q = P + (size_t)(b * SEQ + 256 * qb) * ldp + qmoff + mh * 64; J.qs = ldp;
    J.K = mkv + (size_t)(b * NMEM) * 512 + mh * 64; J.ks = 512; J.V = J.K + 256; J.vs = 512;
    J.O = Y + (size_t)(b * SEQ + 256 * qb) * ldy + yoff + mh * 64; J.os = ldy; J.lse = nullptr; J.ls = 0; J.kbias = nullptr;
    J.kt_lo = 0; J.kt_hi = 4; J.mode = 0; J.q_off = 0; return J;
}
DI void gmlp_unit(int b, int cp, int g, const bf16* P, const float* vst, const float* vg, const bf16* SWj, const float* sb, bf16* Y, LAS unsigned char* lds, int tid, int wid, int lane) {
    typedef float f32x2 __attribute__((ext_vector_type(2)));
    const int R0 = b * SEQ + cp * 256; const int r = lane & 31, h = lane >> 5;
    LAS f32x2* st = (LAS f32x2*)(lds + 256 * TROW);
    if (tid < 256) { const float* p = vst + (size_t)(R0 + tid) * 24; float s1 = 0.f, s2 = 0.f;
#pragma unroll
        for (int k = 0; k < 6; ++k) { const f32x4 t = *(const f32x4*)(p + 4 * k); s1 += t[0] + t[2]; s2 += t[1] + t[3]; }
        const float mean = s1 * (1.0f / 768.0f), var = s2 * (1.0f / 768.0f) - mean * mean; st[tid] = (f32x2){mean, 1.0f / sqrtf(var + LN_EPS)}; }
    __syncthreads();
#pragma unroll
    for (int k = 0; k < 4; ++k) { const int item = tid + 512 * k, row = item >> 3, ch = item & 7;
        const u32x4 raw = *(const u32x4*)(P + (size_t)(R0 + row) * 1792 + 768 + g * 64 + 8 * ch); const f32x2 ms = st[row];
        const f32x4 g0 = *(const f32x4*)(vg + g * 64 + 8 * ch), g1 = *(const f32x4*)(vg + g * 64 + 8 * ch + 4);
        u32x4 w; w.x = pk2((bflo(raw.x) - ms.x) * ms.y * g0[0], (bfhi(raw.x) - ms.x) * ms.y * g0[1]); w.y = pk2((bflo(raw.y) - ms.x) * ms.y * g0[2], (bfhi(raw.y) - ms.x) * ms.y * g0[3]);
        w.z = pk2((bflo(raw.z) - ms.x) * ms.y * g1[0], (bfhi(raw.z) - ms.x) * ms.y * g1[1]); w.w = pk2((bflo(raw.w) - ms.x) * ms.y * g1[2], (bfhi(raw.w) - ms.x) * ms.y * g1[3]);
        *(LAS u32x4*)(lds + row * TROW + ch * 16) = w; }
    __syncthreads();
    const int cl = wid >> 2, tb = wid & 3, t = 32 * tb + r;
    f32x16 o0, o1;
#pragma unroll
    for (int i = 0; i < 16; ++i) { o0[i] = 0.f; o1[i] = 0.f; }
    const bf16* wrow = SWj + ((size_t)g * 128 + t) * 128;
    const int voff = (4 * h + ((lane & 15) >> 2)) * TROW + ((lane >> 4) & 1) * 32 + (lane & 3) * 8;
    const int nsteps = 2 * (tb + 1);
    for (int s = 0; s < nsteps; ++s) {
        const s16x4 lo = *(const s16x4*)(wrow + 16 * s + 4 * h), hi = *(const s16x4*)(wrow + 16 * s + 8 + 4 * h);
        const bf16x8 bfr = __builtin_shufflevector(lo, hi, 0, 1, 2, 3, 4, 5, 6, 7);
        const LAS unsigned char* vl = lds + (128 * cl + 16 * s) * TROW + voff;
        o0 = MFMA32(vfrag(vl), bfr, o0); o1 = MFMA32(vfrag(vl + 64), bfr, o1);
    }
    const size_t row = (size_t)R0 + 128 * cl + t; const float bias = sb[g * 128 + t];
    const bf16* up = P + row * 1792 + g * 64 + 4 * h; bf16* yp = Y + row * 1024 + g * 64 + 4 * h;
#pragma unroll
    for (int q = 0; q < 4; ++q) { const u32x2 u0 = *(const u32x2*)(up + 8 * q), u1 = *(const u32x2*)(up + 32 + 8 * q); u32x2 w0, w1;
        w0.x = pk2((o0[4 * q] + bias) * bflo(u0.x), (o0[4 * q + 1] + bias) * bfhi(u0.x)); w0.y = pk2((o0[4 * q + 2] + bias) * bflo(u0.y), (o0[4 * q + 3] + bias) * bfhi(u0.y));
        w1.x = pk2((o1[4 * q] + bias) * bflo(u1.x), (o1[4 * q + 1] + bias) * bfhi(u1.x)); w1.y = pk2((o1[4 * q + 2] + bias) * bflo(u1.y), (o1[4 * q + 3] + bias) * bfhi(u1.y));
        *(u32x2*)(yp + 8 * q) = w0; *(u32x2*)(yp + 32 + 8 * q) = w1; }
    __syncthreads();
}
#define XB_TMO      128
#define XB_XCNT(j)  (256  + 64 * (j))
#define XB_XSUB(j)  (1280 + 64 * (j))
#define XB_XGEN(j)  (2304 + 64 * (j))
#define XB_TOP      3328
#define XB_TOPGEN   3392
#define XCD_BAR_WORDS 3456
#define XB_SPIN_CAP (1u << 18)

__device__ __forceinline__ unsigned xb_ld(unsigned* p)              { return __hip_atomic_load(p, __ATOMIC_RELAXED, __HIP_MEMORY_SCOPE_AGENT); }
__device__ __forceinline__ unsigned xb_add(unsigned* p, unsigned v) { return __hip_atomic_fetch_add(p, v, __ATOMIC_RELAXED, __HIP_MEMORY_SCOPE_AGENT); }
__device__ __forceinline__ unsigned xb_xcc_id() { return (unsigned)__builtin_amdgcn_s_getreg((3 << 11) | 20) & 0xFu; }
#define XB_SPIN(cond, bar) do { unsigned _sp = 0; while (cond) { __builtin_amdgcn_s_sleep(1); \
    if ((++_sp & 255u) == 0u) { if (xb_ld(&(bar)[XB_TMO])) break; if (_sp > XB_SPIN_CAP) { atomicAdd(&(bar)[XB_TMO], 1u); break; } } } } while (0)

struct XcdBarrier {
    unsigned* bar; unsigned x;
    volatile LAS unsigned* st;
};

__device__ __forceinline__ XcdBarrier xcd_barrier_post(unsigned* bar, volatile LAS unsigned* st) {
    XcdBarrier b; b.bar = bar; b.x = xb_xcc_id(); b.st = st;
    if (threadIdx.x == 0) (void)xb_add(&bar[XB_XCNT(b.x)], 1u);
    return b;
}
__device__ __forceinline__ void xcd_barrier_complete(unsigned* bar, unsigned x, unsigned& nloc, unsigned& nx) {
    const unsigned G = gridDim.x * gridDim.y * gridDim.z;
    unsigned sum, cnt, mine, sp = 0u;
    for (;;) {
        sum = 0u; cnt = 0u; mine = 0u;
#pragma unroll
        for (unsigned j = 0; j < 16; ++j) { const unsigned c = xb_ld(&bar[XB_XCNT(j)]); sum += c; cnt += (c > 0u) ? 1u : 0u; mine = (j == x) ? c : mine; }
        if (sum == G) break;
        __builtin_amdgcn_s_sleep(1);
        if ((++sp & 255u) == 0u) { if (xb_ld(&bar[XB_TMO])) break; if (sp > XB_SPIN_CAP) { atomicAdd(&bar[XB_TMO], 1u); break; } }
    }
    nloc = mine > 0u ? mine : 1u; nx = cnt > 0u ? cnt : 1u;
}

__device__ __forceinline__ void xcd_barrier(const XcdBarrier& b) {
    asm volatile("s_waitcnt vmcnt(0)" ::: "memory");
    __syncthreads();
    if (threadIdx.x == 0) {
        unsigned* bar = b.bar;
        __builtin_amdgcn_s_waitcnt(0);
        unsigned nloc = b.st[0], nx = b.st[1];
        if (nloc == 0u) { xcd_barrier_complete(bar, b.x, nloc, nx); b.st[0] = nloc; b.st[1] = nx; }
        const unsigned old = xb_add(&bar[XB_XSUB(b.x)], 1u);
        const unsigned gen = old / nloc;
        if (old + 1u == (gen + 1u) * nloc) {
            __builtin_amdgcn_fence(__ATOMIC_RELEASE, "agent");
            asm volatile("s_waitcnt vmcnt(0)" ::: "memory");
            const unsigned og = xb_add(&bar[XB_TOP], 1u);
            const unsigned tg = og / nx;
            if (og + 1u == (tg + 1u) * nx) xb_add(&bar[XB_TOPGEN], 1u);
            else XB_SPIN(xb_ld(&bar[XB_TOPGEN]) == tg, bar);
            __builtin_amdgcn_fence(__ATOMIC_ACQUIRE, "agent");
            xb_add(&bar[XB_XGEN(b.x)], 1u);
            asm volatile("s_waitcnt vmcnt(0)" ::: "memory");
        } else {
            XB_SPIN(xb_ld(&bar[XB_XGEN(b.x)]) == gen, bar);
            __builtin_amdgcn_fence(__ATOMIC_ACQUIRE, "agent");
            asm volatile("s_waitcnt vmcnt(0)" ::: "memory");
        }
    }
    __syncthreads();
}

__global__ void __launch_bounds__(512, 2) mega_fwd(Args a) {
    extern __shared__ __attribute__((aligned(16))) unsigned char lds_raw[];
    LAS unsigned char* lds = (LAS unsigned char*)lds_raw;
    cg::grid_group grid = cg::this_grid();
    volatile LAS unsigned* MISC = (volatile LAS unsigned*)(lds + MISC_OFF);
    if (threadIdx.x < 32) MISC[threadIdx.x] = 0u;
    __syncthreads();
    const XcdBarrier bar = xcd_barrier_post((unsigned*)(a.ws + WS_BAR), MISC + 8);
#define INP(T, k) ((const T*)launder_s(a.in[k]))
#define x_in INP(float, 0)
#define mem INP(float, 1)
#define pos INP(int, 2)
#define norm_g INP(float, 3)
#define mem_g INP(float, 4)
#define xres ((float*)launder_s(a.out))
#define WSP(T, off) ((T*)(wsb + (off)))
#define WGU WSP(bf16, WS_WGU)
#define WD WSP(bf16, WS_WD)
#define WINA WSP(bf16, WS_WINA)
#define WINB WSP(bf16, WS_WINB)
#define WINC WSP(bf16, WS_WINC)
#define WOUTA WSP(bf16, WS_WOUTA)
#define WOUTB WSP(bf16, WS_WOUTB)
#define WOUTC WSP(bf16, WS_WOUTC)
#define WMKV WSP(bf16, WS_WMKV)
#define SW WSP(bf16, WS_SW)
#define MEMN WSP(bf16, WS_MEMN)
#define MKV WSP(bf16, WS_MKV)
#define RC WSP(float, WS_RC)
#define RS WSP(float, WS_RS)
#define SSP WSP(float, WS_SSP)
#define VST WSP(float, WS_VST)
#define LOGF WSP(float, WS_LOGF)
#define NEGC WSP(float, WS_NEGC)
#define LSE WSP(float, WS_LSE)
#define XN WSP(bf16, WS_XN)
#define Y WSP(bf16, WS_Y)
#define YO WSP(bf16, WS_YO)
#define OB WSP(bf16, WS_OB)
#define HP WSP(bf16, WS_HP)
    const int ph_end = a.ph_hi < 1 + 12 * DEPTH ? a.ph_hi : 1 + 12 * DEPTH;
    for (int ph = a.ph_lo; ph < ph_end; ++ph) {
        int tid = threadIdx.x; asm volatile("" : "+v"(tid));
        const int lane = tid & 63, wid = __builtin_amdgcn_readfirstlane(tid >> 6);
        int G = gridDim.x, bx = blockIdx.x; asm volatile("" : "+s"(G), "+s"(bx));
        const int gw = bx * 8 + wid, ngw = G * 8;
        unsigned char* wsb = a.ws; asm volatile("" : "+s"(wsb));
        const int layer = ph == 0 ? 0 : (ph - 1) / 12, slot = ph == 0 ? -1 : (ph - 1) % 12, kind = layer % 3, jx = layer / 3;
        if ((slot == 4 && kind != 2) || (slot == 6 && kind != 1)) continue;
        const int f = slot >= 9 ? 1 : 0;
        if (ph == 0) {
            LAS float* scr = (LAS float*)(lds + wid * 16384);
            int base = 0;
            for (int j = 0; j < 28; ++j) {
                const float* W; bf16* WT; int K, Nsrc, Nout, mode = 0;
                if (j < 8) { W = INP(float, 6) + (size_t)j * D * NGU; WT = WGU + (size_t)j * NGU * D; K = D; Nsrc = NGU; Nout = NGU; mode = 1; }
                else if (j < 16) { W = INP(float, 7) + (size_t)(j - 8) * FF * D; WT = WD + (size_t)(j - 8) * D * FF; K = FF; Nsrc = D; Nout = D; }
                else if (j < 18) { W = INP(float, 8) + (size_t)(j - 16) * D * 1792; WT = WINA + (size_t)(j - 16) * 1792 * D; K = D; Nsrc = 1792; Nout = 1792; }
                else if (j == 18) { W = INP(float, 13); WT = WINB; K = D; Nsrc = 2560; Nout = 2560; mode = 2; }
                else if (j == 19) { W = INP(float, 15); WT = WINC; K = D; Nsrc = 2572; Nout = 2816; mode = 3; }
                else if (j < 22) { W = INP(float, 12) + (size_t)(j - 20) * D * D; WT = WOUTA + (size_t)(j - 20) * D * D; K = D; Nsrc = D; Nout = D; }
                else if (j == 22) { W = INP(float, 14); WT = WOUTB; K = 512; Nsrc = D; Nout = D; }
                else if (j == 23) { W = INP(float, 17); WT = WOUTC; K = D; Nsrc = D; Nout = D; }
                else { W = INP(float, 5) + (size_t)(j - 24) * D * 512; WT = WMKV + (size_t)(j - 24) * 512 * D; K = D; Nsrc = 512; Nout = 512; }
                const int nitems = (K / 64) * (Nout / 32);
                for (int it = (gw + ngw - (base % ngw)) % ngw; it < nitems; it += ngw) transpose_item(W, K, Nsrc, WT, Nout, mode, scr, it, lane);
                base += nitems;
            }
            { const float* sw = INP(float, 9); const int n = 2 * 12 * 128 * 128;
              for (int i = bx * 512 + tid; i < n; i += G * 512) { const int t = (i >> 7) & 127, s = i & 127; const float v = s <= t ? sw[i] : 0.f; SW[i] = (bf16)(pk2(v, 0.f) & 0xffffu); } }
            for (int i = bx * 512 + tid; i < M * 32; i += G * 512) { const int row = i >> 5, k = i & 31; const float inv = powf(10000.0f, -(float)(2 * k) / 64.0f); const float ang = (float)pos[row] * inv; RC[i] = cosf(ang); RS[i] = sinf(ang); }
            for (int row = gw; row < NB * NMEM; row += ngw) { f32x4 v[4];
#pragma unroll
                for (int j = 0; j < 4; ++j) v[j] = *(const f32x4*)(mem + (size_t)row * D + 4 * lane + 256 * j);
                for (int l = 0; l < DEPTH; ++l) rms_store(v, mem_g + l * D, MEMN + ((size_t)l * NB * NMEM + row) * D, lane); }
            for (int row = gw; row < M; row += ngw) { f32x4 v[4];
#pragma unroll
                for (int j = 0; j < 4; ++j) v[j] = *(const f32x4*)(x_in + (size_t)row * D + 4 * lane + 256 * j);
                rms_store(v, norm_g, XN + (size_t)row * D, lane); }
        } else if (slot == 0 || slot == 9) {
            if (ph == 1) { pg8::Gemm g{MEMN, WMKV, DEPTH * NB * NMEM, DEPTH * 512, D}; pg8::MemKvOrder S{G, bx}; pg8::EpiPlain E{MKV, 512, 2};
                pg8::gemm_phase<pg8::EpiPlain, pg8::MemKvOrder, true, true>(lds, g, S, E, tid); }
            pg8::Gemm g{XN, WGU + (size_t)(layer * 2 + f) * NGU * D, M, NGU, D}; pg8::StaticOrder S; S.init(M, NGU, G, bx); pg8::EpiSwiglu E{HP, FF};
            pg8::gemm_phase<pg8::EpiSwiglu, pg8::StaticOrder, true, true>(lds, g, S, E, tid);
        } else if (slot == 1 || slot == 10 || slot == 7) {
            pg8::Gemm g;
            if (slot == 7) { g.A = Y; g.Bt = kind == 0 ? WOUTA + (size_t)jx * D * D : (kind == 1 ? WOUTB : WOUTC); g.K = kind == 1 ? 512 : D; }
            else { g.A = HP; g.Bt = WD + (size_t)(layer * 2 + f) * D * FF; g.K = FF; }
            g.M = M; g.N = D;
            pg8::StaticOrder S; S.init(M, D, G, bx); pg8::EpiYss E{YO, SSP};
            pg8::gemm_phase<pg8::EpiYss, pg8::StaticOrder, true, true>(lds, g, S, E, tid);
        } else if (slot == 2 || slot == 11 || slot == 8) {
            const float* g6 = norm_g + (size_t)layer * 6 * D;
            if (slot == 8) norm_pass(xres, YO, SSP, g6 + 3 * D, 1.0f, xres, g6 + 4 * D, XN, gw, ngw, lane);
            else { const float* xin = ph == 3 ? x_in : xres; const float* gnext = slot == 2 ? g6 + 2 * D : (layer + 1 < DEPTH ? g6 + 6 * D : nullptr);
                norm_pass(xin, YO, SSP, g6 + (slot == 2 ? 1 : 5) * D, 0.5f, xres, gnext, XN, gw, ngw, lane); }
        } else if (slot == 3) {
            if (kind == 0) { pg8::Gemm g{XN, WINA + (size_t)jx * 1792 * D, M, 1792, D}; pg8::StaticOrder S; S.init(M, 1792, G, bx); pg8::EpiInA E{HP, VST};
                pg8::gemm_phase<pg8::EpiInA, pg8::StaticOrder, true, true>(lds, g, S, E, tid); }
            else if (kind == 1) { pg8::Gemm g{XN, WINB, M, 2560, D}; pg8::StaticOrder S; S.init(M, 2560, G, bx); pg8::EpiInB E{HP, RC, RS};
                pg8::gemm_phase<pg8::EpiInB, pg8::StaticOrder, true, true>(lds, g, S, E, tid); }
            else { pg8::Gemm g{XN, WINC, M, 2816, D}; pg8::StaticOrder S; S.init(M, 2816, G, bx); pg8::EpiInC E{HP, LOGF, INP(float, 16)};
                pg8::gemm_phase<pg8::EpiInC, pg8::StaticOrder, true, true>(lds, g, S, E, tid); }
        } else if (slot == 4) {
            if (gw < NB * 12) { const int b = gw / 12, hh = gw % 12; const float* lf = LOGF + (size_t)b * SEQ * 12 + hh; float s = 0.f;
                for (int t = 0; t < 64; ++t) s += lf[(size_t)(64 * lane + t) * 12];
                float inc = s;
#pragma unroll
                for (int o = 1; o < 64; o <<= 1) { const float t = __shfl_up(inc, o); if (lane >= o) inc += t; }
                float run = inc - s;
                for (int t = 0; t < 64; ++t) { run += lf[(size_t)(64 * lane + t) * 12]; NEGC[(size_t)gw * SEQ + 64 * lane + t] = -run * LOG2E; } }
        } else if (slot == 5) {
            const bf16* mkv = MKV + (size_t)layer * NB * NMEM * 512;
            if (kind == 0) {
                for (int u = bx; u < 2048; u += G) {
                    if (u < 1536) { const int b = u / 192, rem = u % 192; gmlp_unit(b, rem / 12, rem % 12, HP, VST, INP(float, 11) + jx * 768, SW + (size_t)jx * 12 * 128 * 128, INP(float, 10) + jx * 12 * 128, Y, lds, tid, wid, lane); }
                    else { const AttnJob J = mem_job(u - 1536, HP, 1792, 1536, mkv, Y, 1024, 768); attn_unit(J, lds, tid, wid, lane); }
                }
            } else if (kind == 1) {
                for (int u = bx; u < 2048; u += G) {
                    AttnJob J;
                    if (u < 1536) { const int b = u / 192, rem = u % 192, hd = rem >> 4, w16 = rem & 15, grp = hd >> 2, dil = 1 << (2 * grp), upr = 16 >> (2 * grp), res = w16 / upr, mm = w16 % upr;
                        const size_t brow = (size_t)b * SEQ + res;
                        J.Q = HP + (brow + (size_t)256 * mm * dil) * 2560 + hd * 64; J.qs = (long)dil * 2560;
                        J.K = HP + brow * 2560 + 768 + hd * 64; J.ks = (long)dil * 2560; J.V = J.K + 768; J.vs = J.ks;
                        J.O = OB + (brow + (size_t)256 * mm * dil) * 768 + hd * 64; J.os = (long)dil * 768;
                        J.lse = LSE + (brow + (size_t)256 * mm * dil) * 12 + hd; J.ls = (long)dil * 12; J.kbias = nullptr;
                        J.kt_lo = mm == 0 ? 0 : 4 * mm - 2; J.kt_hi = 4 * mm + 4; J.mode = 2; J.q_off = 256 * mm; }
                    else J = mem_job(u - 1536, HP, 2560, 2304, mkv, Y, 512, 256);
                    attn_unit(J, lds, tid, wid, lane);
                }
            } else {
                for (int p = bx; p < 768 * 2 + 512; p += G) {
                    AttnJob J;
                    if (p < 1536) { const int pr = p % 768, k = p / 768, bh = pr >> 3, s = pr & 7, b = bh / 12, hh = bh % 12, qb = k == 0 ? s : 15 - s;
                        J.Q = HP + ((size_t)b * SEQ + 256 * qb) * 2560 + hh * 64; J.qs = 2560; J.K = HP + (size_t)b * SEQ * 2560 + 768 + hh * 64; J.ks = 2560; J.V = J.K + 768; J.vs = 2560;
                        J.O = Y + ((size_t)b * SEQ + 256 * qb) * 1024 + hh * 64; J.os = 1024; J.lse = nullptr; J.ls = 0; J.kbias = NEGC + (size_t)bh * SEQ;
                        J.kt_lo = 0; J.kt_hi = 4 * qb + 4; J.mode = 1; J.q_off = 256 * qb; }
                    else J = mem_job(p - 1536, HP, 2560, 2304, mkv, Y, 1024, 768);
                    attn_unit(J, lds, tid, wid, lane);
                }
            }
        } else if (slot == 6) {
            for (int i = bx * 512 + tid; i < M * 32; i += G * 512) { const int row = i >> 5, hg = (i >> 3) & 3, ch = i & 7;
                const float l0 = LSE[(size_t)row * 12 + hg], l1 = LSE[(size_t)row * 12 + 4 + hg], l2 = LSE[(size_t)row * 12 + 8 + hg];
                const float mx = fmaxf(l0, fmaxf(l1, l2)); float w0 = expf(l0 - mx), w1 = expf(l1 - mx), w2 = expf(l2 - mx); const float inv = 1.0f / (w0 + w1 + w2); w0 *= inv; w1 *= inv; w2 *= inv;
                const u32x4 a0 = *(const u32x4*)(OB + (size_t)row * 768 + hg * 64 + 8 * ch), a1 = *(const u32x4*)(OB + (size_t)row * 768 + (4 + hg) * 64 + 8 * ch), a2 = *(const u32x4*)(OB + (size_t)row * 768 + (8 + hg) * 64 + 8 * ch);
                u32x4 o;
                o.x = pk2(w0 * bflo(a0.x) + w1 * bflo(a1.x) + w2 * bflo(a2.x), w0 * bfhi(a0.x) + w1 * bfhi(a1.x) + w2 * bfhi(a2.x));
                o.y = pk2(w0 * bflo(a0.y) + w1 * bflo(a1.y) + w2 * bflo(a2.y), w0 * bfhi(a0.y) + w1 * bfhi(a1.y) + w2 * bfhi(a2.y));
                o.z = pk2(w0 * bflo(a0.z) + w1 * bflo(a1.z) + w2 * bflo(a2.z), w0 * bfhi(a0.z) + w1 * bfhi(a1.z) + w2 * bfhi(a2.z));
                o.w = pk2(w0 * bflo(a0.w) + w1 * bflo(a1.w) + w2 * bflo(a2.w), w0 * bfhi(a0.w) + w1 * bfhi(a1.w) + w2 * bfhi(a2.w));
                *(u32x4*)(Y + (size_t)row * 512 + hg * 64 + 8 * ch) = o; }
        }
        if (ph + 1 < ph_end) { if (ph == a.ph_lo) grid.sync(); else xcd_barrier(bar); }
    }
}

extern "C" void kernel_launch(void* const* d_in, const int* in_sizes, int n_in, void* d_out, int out_size, void* d_ws, size_t ws_size, hipStream_t stream) {
    static int grid = 0;
    if (grid == 0) {
        if (n_in != 18 || out_size != M * D || ws_size < WS_END) { fprintf(stderr, "kernel_launch: unexpected problem: n_in %d out %d ws %zu (need %zu)\n", n_in, out_size, ws_size, (size_t)WS_END); grid = -1; return; }
        int dev = 0, cus = 0, per_cu = 0;
        hipGetDevice(&dev); hipDeviceGetAttribute(&cus, hipDeviceAttributeMultiprocessorCount, dev);
        if (hipFuncSetAttribute((const void*)mega_fwd, hipFuncAttributeMaxDynamicSharedMemorySize, LDS_BYTES) != hipSuccess) { fprintf(stderr, "kernel_launch: hipFuncSetAttribute failed\n"); grid = -1; return; }
        if (hipOccupancyMaxActiveBlocksPerMultiprocessor(&per_cu, (const void*)mega_fwd, 512, LDS_BYTES) != hipSuccess || per_cu < 1) { fprintf(stderr, "kernel_launch: occupancy query says %d\n", per_cu); per_cu = 1; }
        (void)hipGetLastError();
        grid = cus * 1;
    }
    if (grid < 0) return;
    if (hipMemsetAsync(d_ws, 0, CTL_ZERO_BYTES, stream) != hipSuccess) { fprintf(stderr, "kernel_launch: memset failed\n"); return; }
    Args a{};
    for (int i = 0; i < 18; ++i) a.in[i] = d_in[i];
    a.out = (float*)d_out; a.ws = (unsigned char*)d_ws; a.ph_lo = 0; a.ph_hi = 1 + 12 * DEPTH;
    void* args[] = {&a};
    hipError_t e = hipLaunchCooperativeKernel((const void*)mega_fwd, dim3(grid), dim3(512), args, LDS_BYTES, stream);
    if (e != hipSuccess) fprintf(stderr, "cooperative launch failed: %s (grid %d)\n", hipGetErrorString(e), grid);
}
```
